# Optimizing an MI355X kernel written in HIP

```python
import math
import jax
import jax.numpy as jnp
from jax import lax
import numpy as np

D_MODEL = 1024
BATCH = 8
SEQ = 2048
DEPTH = 4

GRID_W = 64
CTX_LEN = 256
A_HEADS = 4
A_DQK = 64
A_DV = 128
B_HEADS = 8
B_KV_HEADS = 2
B_DH = 64
C_HEADS = 4
C_DK = 128
C_DV = 128
C_CONV = 3
BRANCH_W = A_HEADS * A_DV
D_FF = 2816
FFN_CONV = 3
CHUNK = 64
Q_BLOCK = 128
ROPE_BASE = 10000.0
EPS = 1e-6
M_INIT = -1e30
IN_SPLIT = (A_HEADS * A_DQK, A_HEADS * A_DQK, A_HEADS * A_DV, A_HEADS * A_DV, 4 * A_HEADS,
            B_HEADS * B_DH, B_KV_HEADS * B_DH, B_KV_HEADS * B_DH,
            C_HEADS * C_DK, C_HEADS * C_DK, C_HEADS * C_DV, C_HEADS * C_DV, 2 * C_HEADS, 2 * C_HEADS,
            3 * D_MODEL)
IN_COLS = sum(IN_SPLIT)

kernel_name = 'hybrid_mlstm_gqa_gdn_dit'


def rmsnorm(x, w):
    xf = x.astype(jnp.float32)
    y = xf * lax.rsqrt(jnp.mean(xf * xf, axis=-1, keepdims=True) + EPS)
    return (y * w.astype(jnp.float32)).astype(x.dtype)


def l2norm(x):
    return x * lax.rsqrt(jnp.sum(x * x, axis=-1, keepdims=True) + EPS)


def modulate(x, shift, scale):
    return x * (1 + scale) + shift


def to_heads(u, n):
    b, t, _ = u.shape
    return u.reshape(b, t, n, -1).transpose(0, 2, 1, 3)


def from_heads(u):
    b, n, t, d = u.shape
    return u.transpose(0, 2, 1, 3).reshape(b, t, n * d)


def flip_t(u):
    return jnp.flip(u, axis=2)


def split_in(u):
    idx = np.cumsum(IN_SPLIT)[:-1].tolist()
    return jnp.split(u, idx, axis=-1)


def dwconv(u, w):
    k = w.shape[0]
    p = k // 2
    t = u.shape[1]
    up = jnp.pad(u, ((0, 0), (p, p), (0, 0)))
    out = up[:, 0:t] * w[0]
    for j in range(1, k):
        out = out + up[:, j:j + t] * w[j]
    return out


def axial_rope_tables(n_tok):
    rows = n_tok // GRID_W
    row = jnp.repeat(jnp.arange(rows, dtype=jnp.float32), GRID_W)
    col = jnp.tile(jnp.arange(GRID_W, dtype=jnp.float32), rows)
    n_freq = B_DH // 4
    inv = ROPE_BASE ** (-jnp.arange(n_freq, dtype=jnp.float32) / n_freq)
    ang = jnp.stack([row[:, None] * inv, col[:, None] * inv], axis=1)
    return jnp.cos(ang), jnp.sin(ang)


def apply_rope(x, cos, sin):
    b, h, t, d = x.shape
    xr = x.astype(jnp.float32).reshape(b, h, t, 2, 2, d // 4)
    x1, x2 = xr[..., 0, :], xr[..., 1, :]
    out = jnp.stack([x1 * cos - x2 * sin, x2 * cos + x1 * sin], axis=-2)
    return out.reshape(b, h, t, d).astype(x.dtype)


def blocked_attention(q, k, v):
    b, hq, t, d = q.shape
    hkv = k.shape[1]
    g = hq // hkv
    nb = t // Q_BLOCK
    qb = q.reshape(b, hkv, g, nb, Q_BLOCK, d).transpose(3, 0, 1, 2, 4, 5).astype(jnp.float32) * (d ** -0.5)
    kf = k.astype(jnp.float32)
    vf = v.astype(jnp.float32)

    def one_block(qi):
        s = jnp.einsum('bkgqd,bktd->bkgqt', qi, kf)
        p = jax.nn.softmax(s, axis=-1)
        return jnp.einsum('bkgqt,bktd->bkgqd', p, vf)

    o = lax.map(one_block, qb)
    return o.transpose(1, 2, 3, 0, 4, 5).reshape(b, hq, t, d).astype(q.dtype)


def mlstm_scan(q, k, v, logi, logf, state):
    b, h, t, dk = q.shape
    dv = v.shape[-1]
    nc = t // CHUNK
    tri = jnp.tril(jnp.ones((CHUNK, CHUNK), bool))

    def chunks(u):
        return jnp.moveaxis(u.reshape(b, h, nc, CHUNK, *u.shape[3:]), 2, 0)

    def step(carry, inp):
        C, n, m = carry
        qc, kc, vc, ic, fc = inp
        bcum = jnp.cumsum(fc, axis=-1)
        dlog = jnp.where(tri, bcum[..., :, None] - bcum[..., None, :] + ic[..., None, :], -jnp.inf)
        inter = bcum + m[..., None]
        mt = jnp.maximum(inter, jnp.max(dlog, axis=-1))
        s = jnp.einsum('bhtd,bhsd->bhts', qc, kc) * jnp.exp(dlog - mt[..., None])
        e_inter = jnp.exp(inter - mt)
        num = jnp.einsum('bhts,bhse->bhte', s, vc) + e_inter[..., None] * jnp.einsum('bhtd,bhde->bhte', qc, C)
        den = jnp.sum(s, axis=-1) + e_inter * jnp.einsum('bhtd,bhd->bht', qc, n)
        hc = num / jnp.maximum(jnp.abs(den), jnp.exp(-mt))[..., None]
        btot = bcum[..., -1]
        glog = btot[..., None] - bcum + ic
        m_new = jnp.maximum(btot + m, jnp.max(glog, axis=-1))
        wk = jnp.exp(glog - m_new[..., None])
        decay = jnp.exp(btot + m - m_new)
        C_new = decay[..., None, None] * C + jnp.einsum('bhs,bhsd,bhse->bhde', wk, kc, vc)
        n_new = decay[..., None] * n + jnp.einsum('bhs,bhsd->bhd', wk, kc)
        return (C_new, n_new, m_new), hc

    carry, hs = lax.scan(step, state, (chunks(q), chunks(k), chunks(v), chunks(logi), chunks(logf)))
    return jnp.moveaxis(hs, 0, 2).reshape(b, h, t, dv), carry


def gdn_scan(q, k, v, g, beta, S0):
    b, h, t, dk = q.shape
    dv = v.shape[-1]
    nc = t // CHUNK

    def ch(u):
        return u.reshape(b, h, nc, CHUNK, *u.shape[3:])

    q, k, v, g, beta = ch(q), ch(k), ch(v), ch(g), ch(beta)
    tri = jnp.tril(jnp.ones((CHUNK, CHUNK), bool))
    stri = jnp.tril(jnp.ones((CHUNK, CHUNK), bool), -1)
    G = jnp.cumsum(g, axis=-1)
    decay = jnp.exp(jnp.where(tri, G[..., :, None] - G[..., None, :], -jnp.inf))
    kb = k * beta[..., None]
    A = jnp.where(stri, jnp.einsum('bhntd,bhnsd->bhnts', kb, k) * decay, 0.0)
    eye = jnp.eye(CHUNK, dtype=A.dtype)
    T = lax.linalg.triangular_solve(A + eye, jnp.broadcast_to(eye, A.shape),
                                    left_side=True, lower=True, unit_diagonal=True)
    u = T @ (v * beta[..., None])
    w = T @ (kb * jnp.exp(G)[..., None])
    qk = jnp.where(tri, jnp.einsum('bhntd,bhnsd->bhnts', q, k) * decay, 0.0)
    qg = q * jnp.exp(G)[..., None]
    g_last = G[..., -1]
    kg = k * jnp.exp(g_last[..., None] - G)[..., None]

    def step(S, inp):
        u_c, w_c, qk_c, qg_c, kg_c, gl_c = inp
        v_new = u_c - w_c @ S
        o = qg_c @ S + qk_c @ v_new
        S = S * jnp.exp(gl_c)[..., None, None] + jnp.einsum('bhsd,bhse->bhde', kg_c, v_new)
        return S, o

    xs = (jnp.moveaxis(u, 2, 0), jnp.moveaxis(w, 2, 0), jnp.moveaxis(qk, 2, 0),
          jnp.moveaxis(qg, 2, 0), jnp.moveaxis(kg, 2, 0), jnp.moveaxis(g_last, 2, 0))
    S, o = lax.scan(step, S0, xs)
    return jnp.moveaxis(o, 0, 2).reshape(b, h, t, dv), S


def mlstm_branch(pc, pl, gate_b, norm_w, need_ctx):
    def prep(p):
        q, k, v, o, g = p
        b, t, _ = q.shape
        q = to_heads(q, A_HEADS).astype(jnp.float32) * (A_DQK ** -0.5)
        k = to_heads(k, A_HEADS).astype(jnp.float32)
        v = to_heads(v, A_HEADS).astype(jnp.float32)
        g = (g.astype(jnp.float32) + gate_b.reshape(-1).astype(jnp.float32)).reshape(b, t, 4, A_HEADS).transpose(2, 0, 3, 1)
        return q, k, v, g, o

    qc, kc, vc, gc, oc = prep(pc)
    ql, kl, vl, gl, ol = prep(pl)
    b = ql.shape[0]
    init = (jnp.zeros((b, A_HEADS, A_DQK, A_DV), jnp.float32),
            jnp.zeros((b, A_HEADS, A_DQK), jnp.float32),
            jnp.full((b, A_HEADS), M_INIT, jnp.float32))
    lsig = jax.nn.log_sigmoid
    hcf, st = mlstm_scan(qc, kc, vc, gc[0], lsig(gc[1]), init)
    hlf, _ = mlstm_scan(ql, kl, vl, gl[0], lsig(gl[1]), st)
    hcb, st = mlstm_scan(flip_t(qc), flip_t(kc), flip_t(vc), flip_t(gc[2]), lsig(flip_t(gc[3])), init)
    hlb, _ = mlstm_scan(flip_t(ql), flip_t(kl), flip_t(vl), flip_t(gl[2]), lsig(flip_t(gl[3])), st)

    def post(hsum, o):
        hn = hsum * lax.rsqrt(jnp.mean(hsum * hsum, axis=-1, keepdims=True) + EPS)
        return (from_heads(hn) * norm_w.astype(jnp.float32) * jax.nn.sigmoid(o.astype(jnp.float32))).astype(o.dtype)

    y_lat = post(hlf + flip_t(hlb), ol)
    y_ctx = post(hcf + flip_t(hcb), oc) if need_ctx else None
    return y_ctx, y_lat


def gqa_branch(pc, pl, qn_w, kn_w, cos, sin, need_ctx):
    def prep(p):
        q, k, v = p
        return (rmsnorm(to_heads(q, B_HEADS), qn_w), rmsnorm(to_heads(k, B_KV_HEADS), kn_w),
                to_heads(v, B_KV_HEADS))

    qc, kc, vc = prep(pc)
    ql, kl, vl = prep(pl)
    ql = apply_rope(ql, cos, sin)
    kl = apply_rope(kl, cos, sin)
    k_all = jnp.concatenate([kc, kl], axis=2)
    v_all = jnp.concatenate([vc, vl], axis=2)
    y_lat = from_heads(blocked_attention(ql, k_all, v_all))
    y_ctx = from_heads(blocked_attention(qc, kc, vc)) if need_ctx else None
    return y_ctx, y_lat


def gdn_branch(pc, pl, conv_w, a_log, dt_bias, norm_w, need_ctx):
    def prep(p):
        q, k, v, z, a, beta = p
        b, t, _ = q.shape
        qkv = jax.nn.silu(dwconv(jnp.concatenate([q, k, v], axis=-1), conv_w))
        q, k, v = jnp.split(qkv, [C_HEADS * C_DK, 2 * C_HEADS * C_DK], axis=-1)
        q = l2norm(to_heads(q, C_HEADS).astype(jnp.float32)) * (C_DK ** -0.5)
        k = l2norm(to_heads(k, C_HEADS).astype(jnp.float32))
        v = to_heads(v, C_HEADS).astype(jnp.float32)
        a = a.astype(jnp.float32).reshape(b, t, 2, C_HEADS) + dt_bias.astype(jnp.float32)
        g = (-jnp.exp(a_log.astype(jnp.float32)) * jax.nn.softplus(a)).transpose(2, 0, 3, 1)
        beta = jax.nn.sigmoid(beta.astype(jnp.float32).reshape(b, t, 2, C_HEADS)).transpose(2, 0, 3, 1)
        return q, k, v, g, beta, z

    qc, kc, vc, gc, bc, zc = prep(pc)
    ql, kl, vl, gl, bl, zl = prep(pl)
    b = ql.shape[0]
    s0 = jnp.zeros((b, C_HEADS, C_DK, C_DV), jnp.float32)
    ocf, st = gdn_scan(qc, kc, vc, gc[0], bc[0], s0)
    olf, _ = gdn_scan(ql, kl, vl, gl[0], bl[0], st)
    ocb, st = gdn_scan(flip_t(qc), flip_t(kc), flip_t(vc), flip_t(gc[1]), flip_t(bc[1]), s0)
    olb, _ = gdn_scan(flip_t(ql), flip_t(kl), flip_t(vl), flip_t(gl[1]), flip_t(bl[1]), st)

    def post(osum, z):
        on = osum * lax.rsqrt(jnp.mean(osum * osum, axis=-1, keepdims=True) + EPS) * norm_w.astype(jnp.float32)
        return (from_heads(on) * jax.nn.silu(z.astype(jnp.float32))).astype(z.dtype)

    y_lat = post(olf + flip_t(olb), zl)
    y_ctx = post(ocf + flip_t(ocb), zc) if need_ctx else None
    return y_ctx, y_lat


def merge_branches(ya, yb, yc, gate_pre, wb, wo):
    ga, gb, gc = jnp.split(jax.nn.sigmoid(gate_pre), 3, axis=-1)
    y = ga * (ya @ wb[0]) + gb * (yb @ wb[1]) + gc * (yc @ wb[2])
    return y @ wo


def conv_ffn(xn, w_up, conv_w, w_down):
    u = dwconv(xn @ w_up, conv_w)
    a, gt = jnp.split(u, 2, axis=-1)
    return (a * jax.nn.silu(gt)) @ w_down


def setup_inputs(seed: int = 0) -> dict:
    key = jax.random.key(seed)
    ks = jax.random.split(key, 24)

    def nrm(k, shape, s):
        return jax.random.normal(k, shape, jnp.float32) * s

    dt = jnp.exp(jax.random.uniform(ks[15], (DEPTH, 2, C_HEADS), jnp.float32,
                                    minval=math.log(1e-3), maxval=math.log(1e-1)))
    return {
        'x': nrm(ks[0], (BATCH, SEQ, D_MODEL), 1.0),
        'c': nrm(ks[1], (BATCH, D_MODEL), 1.0),
        'ctx': nrm(ks[2], (BATCH, CTX_LEN, D_MODEL), 1.0),
        'c_ctx': nrm(ks[3], (D_MODEL,), 1.0),
        'norm1_w': 1.0 + nrm(ks[4], (DEPTH, D_MODEL), 0.05),
        'norm2_w': 1.0 + nrm(ks[5], (DEPTH, D_MODEL), 0.05),
        'ada_w': nrm(ks[6], (DEPTH, D_MODEL, 6 * D_MODEL), 0.5 * D_MODEL ** -0.5),
        'ada_b': nrm(ks[7], (DEPTH, 6 * D_MODEL), 0.02),
        'w_in': nrm(ks[8], (DEPTH, D_MODEL, IN_COLS), D_MODEL ** -0.5),
        'a_gate_b': jnp.array([0.0, 3.0, 0.0, 3.0], jnp.float32)[None, :, None] + nrm(ks[9], (DEPTH, 4, A_HEADS), 0.1),
        'a_norm_w': 1.0 + nrm(ks[10], (DEPTH, A_HEADS * A_DV), 0.05),
        'b_qnorm_w': 1.0 + nrm(ks[11], (DEPTH, B_DH), 0.05),
        'b_knorm_w': 1.0 + nrm(ks[12], (DEPTH, B_DH), 0.05),
        'c_conv_w': nrm(ks[13], (DEPTH, C_CONV, 2 * C_HEADS * C_DK + C_HEADS * C_DV), C_CONV ** -0.5),
        'c_a_log': jnp.log(jax.random.uniform(ks[14], (DEPTH, 2, C_HEADS), jnp.float32, minval=1.0, maxval=16.0)),
        'c_dt_bias': dt + jnp.log(-jnp.expm1(-dt)),
        'c_norm_w': 1.0 + nrm(ks[16], (DEPTH, C_DV), 0.05),
        'w_branch': nrm(ks[17], (DEPTH, 3, BRANCH_W, D_MODEL), BRANCH_W ** -0.5),
        'w_out': nrm(ks[18], (DEPTH, D_MODEL, D_MODEL), D_MODEL ** -0.5),
        'w_up': nrm(ks[19], (DEPTH, D_MODEL, 2 * D_FF), D_MODEL ** -0.5),
        'ffn_conv_w': nrm(ks[20], (DEPTH, FFN_CONV, 2 * D_FF), FFN_CONV ** -0.5),
        'w_down': nrm(ks[21], (DEPTH, D_FF, D_MODEL), D_FF ** -0.5),
    }


def reference(x, c, ctx, c_ctx, norm1_w, norm2_w, ada_w, ada_b, w_in, a_gate_b, a_norm_w,
              b_qnorm_w, b_knorm_w, c_conv_w, c_a_log, c_dt_bias, c_norm_w, w_branch, w_out,
              w_up, ffn_conv_w, w_down):
    cos, sin = axial_rope_tables(x.shape[1])
    silu_c = jax.nn.silu(c)
    silu_cc = jax.nn.silu(c_ctx)
    h_lat, h_ctx = x, ctx
    for l in range(DEPTH):
        need_ctx = l < DEPTH - 1
        m_lat = jnp.split((silu_c @ ada_w[l] + ada_b[l])[:, None, :], 6, axis=-1)
        m_ctx = jnp.split((silu_cc @ ada_w[l] + ada_b[l])[None, None, :], 6, axis=-1)
        xn_lat = modulate(rmsnorm(h_lat, norm1_w[l]), m_lat[0], m_lat[1])
        xn_ctx = modulate(rmsnorm(h_ctx, norm1_w[l]), m_ctx[0], m_ctx[1])
        p_lat = split_in(xn_lat @ w_in[l])
        p_ctx = split_in(xn_ctx @ w_in[l])
        ya_ctx, ya_lat = mlstm_branch(p_ctx[0:5], p_lat[0:5], a_gate_b[l], a_norm_w[l], need_ctx)
        yb_ctx, yb_lat = gqa_branch(p_ctx[5:8], p_lat[5:8], b_qnorm_w[l], b_knorm_w[l], cos, sin, need_ctx)
        yc_ctx, yc_lat = gdn_branch(p_ctx[8:14], p_lat[8:14], c_conv_w[l], c_a_log[l], c_dt_bias[l],
                                    c_norm_w[l], need_ctx)
        h_lat = h_lat + m_lat[2] * merge_branches(ya_lat, yb_lat, yc_lat, p_lat[14], w_branch[l], w_out[l])
        h_lat = h_lat + m_lat[5] * conv_ffn(modulate(rmsnorm(h_lat, norm2_w[l]), m_lat[3], m_lat[4]),
                                            w_up[l], ffn_conv_w[l], w_down[l])
        if need_ctx:
            h_ctx = h_ctx + m_ctx[2] * merge_branches(ya_ctx, yb_ctx, yc_ctx, p_ctx[14], w_branch[l], w_out[l])
            h_ctx = h_ctx + m_ctx[5] * conv_ffn(modulate(rmsnorm(h_ctx, norm2_w[l]), m_ctx[3], m_ctx[4]),
                                                w_up[l], ffn_conv_w[l], w_down[l])
    return h_lat
```

```cpp
#include <hip/hip_runtime.h>
#include <hip/hip_cooperative_groups.h>
namespace cg = cooperative_groups;

typedef unsigned short bf16_t;
typedef short bf16x8 __attribute__((ext_vector_type(8)));
typedef float f32x16 __attribute__((ext_vector_type(16)));
typedef __bf16 bf2v __attribute__((ext_vector_type(2)));
typedef float f2v __attribute__((ext_vector_type(2)));
typedef unsigned u32x4 __attribute__((ext_vector_type(4)));
typedef unsigned u32x2 __attribute__((ext_vector_type(2)));
#define DI __device__ __forceinline__

constexpr int D = 1024, NB = 8, SEQ = 2048, CTX = 256, TT = 2304  , M = NB * TT  ;
constexpr int DEPTH = 4, INC = 7456, DFF = 2816, PLD = 4352;
constexpr int P_AQ = 0, P_AK = 256, P_AV = 512, P_AO = 1024, P_BQ = 1536, P_BK = 2048, P_BV = 2176, P_CQ = 2304, P_CZ = 3840;
constexpr int NIN = 4480;
constexpr size_t W_IN = 0, W_G = W_IN + (size_t)NIN * 1024, W_B = W_G + (size_t)3072 * 1024, W_O = W_B + (size_t)3 * 1024 * 512,
                 W_UP = W_O + (size_t)1024 * 1024, W_DN = W_UP + (size_t)5632 * 1024, W_END = W_DN + (size_t)1024 * 2816;
constexpr size_t OFF_WBF = 0;
constexpr size_t OFF_HCTX = OFF_WBF + W_END * 2;
constexpr size_t OFF_XN = OFF_HCTX + (size_t)NB * CTX * D * 4;
constexpr size_t OFF_BIG = OFF_XN + (size_t)M * D * 2;
constexpr size_t OFF_HSA = OFF_BIG + (size_t)M * PLD * 2;
constexpr size_t OFF_Y = OFF_BIG + (size_t)M * 5632 * 2;
constexpr size_t OFF_ACT = OFF_Y + (size_t)M * 1536 * 2;
constexpr size_t OFF_HSC = OFF_ACT + (size_t)M * 1536 * 2;
constexpr size_t OFF_GATES = OFF_ACT + (size_t)M * DFF * 2;
constexpr size_t OFF_VT = OFF_GATES + (size_t)M * 32 * 4;
constexpr size_t OFF_MOD = OFF_VT + (size_t)NB * 2 * 64 * TT * 2;
constexpr size_t OFF_ROPE = OFF_MOD + (size_t)DEPTH * 9 * 6144 * 4;
constexpr size_t OFF_BAR = OFF_ROPE + 2048 * 4;
constexpr size_t OFF_AUX = OFF_BAR + 16384;
constexpr size_t OFF_JUNK = OFF_AUX + (size_t)M * 32 * 4;
constexpr size_t OFF_EDGE = OFF_JUNK + 1048576;
constexpr size_t OFF_END = OFF_EDGE + (size_t)72 * 44 * 4 * 128 * 2;
static_assert(OFF_HSA + (size_t)M * 512 * 4 <= OFF_Y, "hsum A fits");
static_assert(OFF_HSC + (size_t)M * 512 * 4 <= OFF_GATES, "hsum C fits");

struct Params {
  const float *x, *c, *ctx, *c_ctx, *norm1_w, *norm2_w, *ada_w, *ada_b, *w_in, *a_gate_b, *a_norm_w, *b_qnorm_w, *b_knorm_w,
      *c_conv_w, *c_a_log, *c_dt_bias, *c_norm_w, *w_branch, *w_out, *w_up, *ffn_conv_w, *w_down;
  float* out;
  char* ws;
};

DI int tid_() { int t = threadIdx.x; asm volatile("" : "+v"(t)); return t; }
DI int bid_() { int b = blockIdx.x; asm volatile("" : "+s"(b)); return b; }
DI unsigned pk2(float a, float b) { f2v v = {a, b}; return __builtin_bit_cast(unsigned, __builtin_convertvector(v, bf2v)); }
DI u32x4 mk4(unsigned a, unsigned b, unsigned c, unsigned d) { u32x4 r = {a, b, c, d}; return r; }
DI u32x2 mk2(unsigned a, unsigned b) { u32x2 r = {a, b}; return r; }
DI float bflo(unsigned u) { return __uint_as_float(u << 16); }
DI float bfhi(unsigned u) { return __uint_as_float(u & 0xffff0000u); }
DI float bf2f(bf16_t u) { return __uint_as_float(((unsigned)u) << 16); }
DI bf16_t f2bf(float a) { return (bf16_t)(pk2(a, 0.f) & 0xffffu); }
DI float wsum(float v) {
#pragma unroll
  for (int o = 32; o; o >>= 1) v += __shfl_xor(v, o);
  return v;
}
DI float dpp_xor1(float v) { return __builtin_bit_cast(float, __builtin_amdgcn_update_dpp(0, __builtin_bit_cast(int, v), 0xB1, 0xF, 0xF, true)); }
DI float dpp_xor2(float v) { return __builtin_bit_cast(float, __builtin_amdgcn_update_dpp(0, __builtin_bit_cast(int, v), 0x4E, 0xF, 0xF, true)); }
DI float sigmoidf_(float x) { return 1.f / (1.f + __expf(-x)); }
DI float siluf_(float x) { return x / (1.f + __expf(-x)); }
DI float logsigmoidf_(float x) { return fminf(x, 0.f) - __logf(1.f + __expf(-fabsf(x))); }
DI float softplusf_(float x) { return fmaxf(x, 0.f) + __logf(1.f + __expf(-fabsf(x))); }
DI void unpack8(u32x4 u, float* f) {
  f[0] = bflo(u.x); f[1] = bfhi(u.x); f[2] = bflo(u.y); f[3] = bfhi(u.y);
  f[4] = bflo(u.z); f[5] = bfhi(u.z); f[6] = bflo(u.w); f[7] = bfhi(u.w);
}
DI float* hrow(const Params& p, int row) {
  int b = row / TT, t = row - b * TT;
  return t < CTX ? (float*)(p.ws + OFF_HCTX) + (size_t)(b * CTX + t) * D : p.out + (size_t)(b * SEQ + t - CTX) * D;
}


#define XB_TMO      128
#define XB_XCNT(j)  (256  + 64 * (j))
#define XB_XSUB(j)  (1280 + 64 * (j))
#define XB_XGEN(j)  (2304 + 64 * (j))
#define XB_TOP      3328
#define XB_TOPGEN   3392
#define XCD_BAR_WORDS 3456
#define XB_SPIN_CAP (1u << 22)
#define LAS __attribute__((address_space(3)))
DI unsigned xb_ld(unsigned* p) { return __hip_atomic_load(p, __ATOMIC_RELAXED, __HIP_MEMORY_SCOPE_AGENT); }
DI unsigned xb_add(unsigned* p, unsigned v) { return __hip_atomic_fetch_add(p, v, __ATOMIC_RELAXED, __HIP_MEMORY_SCOPE_AGENT); }
DI unsigned xb_xcc_id() { return (unsigned)__builtin_amdgcn_s_getreg((3 << 11) | 20) & 0xFu; }
#define XB_SPIN(cond, bar) do { unsigned _sp = 0; while (cond) { __builtin_amdgcn_s_sleep(1); \
    if ((++_sp & 255u) == 0u) { if (xb_ld(&(bar)[XB_TMO])) break; if (_sp > XB_SPIN_CAP) { atomicAdd(&(bar)[XB_TMO], 1u); break; } } } } while (0)
struct XcdBarrier { unsigned* bar; unsigned x; volatile LAS unsigned* st; };
DI XcdBarrier xcd_barrier_post(unsigned* bar, volatile LAS unsigned* st) {
  XcdBarrier b; b.bar = bar; b.x = xb_xcc_id(); b.st = st;
  if (threadIdx.x == 0) (void)xb_add(&bar[XB_XCNT(b.x)], 1u);
  return b;
}
DI void xcd_barrier_complete(unsigned* bar, unsigned x, unsigned& nloc, unsigned& nx) {
  const unsigned G = gridDim.x;
  unsigned sum, cnt, mine, sp = 0u;
  for (;;) {
    sum = 0u; cnt = 0u; mine = 0u;
#pragma unroll
    for (unsigned j = 0; j < 16; ++j) { const unsigned c = xb_ld(&bar[XB_XCNT(j)]); sum += c; cnt += (c > 0u) ? 1u : 0u; mine = (j == x) ? c : mine; }
    if (sum == G) break;
    __builtin_amdgcn_s_sleep(1);
    if ((++sp & 255u) == 0u) { if (xb_ld(&bar[XB_TMO])) break; if (sp > XB_SPIN_CAP) { atomicAdd(&bar[XB_TMO], 1u); break; } }
  }
  nloc = mine > 0u ? mine : 1u; nx = cnt > 0u ? cnt : 1u;
}
DI void xcd_barrier(const XcdBarrier& b) {
  asm volatile("s_waitcnt vmcnt(0)" ::: "memory");
  __syncthreads();
  if (threadIdx.x == 0) {
    unsigned* bar = b.bar;
    __builtin_amdgcn_s_waitcnt(0);
    unsigned nloc = b.st[0], nx = b.st[1];
    if (nloc == 0u) { xcd_barrier_complete(bar, b.x, nloc, nx); b.st[0] = nloc; b.st[1] = nx; }
    const unsigned old = xb_add(&bar[XB_XSUB(b.x)], 1u);
    const unsigned gen = old / nloc;
    if (old + 1u == (gen + 1u) * nloc) {
      __builtin_amdgcn_fence(__ATOMIC_RELEASE, "agent");
      asm volatile("s_waitcnt vmcnt(0)" ::: "memory");
      const unsigned og = xb_add(&bar[XB_TOP], 1u);
      const unsigned tg = og / nx;
      if (og + 1u == (tg + 1u) * nx) xb_add(&bar[XB_TOPGEN], 1u);
      else XB_SPIN(xb_ld(&bar[XB_TOPGEN]) == tg, bar);
      __builtin_amdgcn_fence(__ATOMIC_ACQUIRE, "agent");
      xb_add(&bar[XB_XGEN(b.x)], 1u);
      asm volatile("s_waitcnt vmcnt(0)" ::: "memory");
    } else {
      XB_SPIN(xb_ld(&bar[XB_XGEN(b.x)]) == gen, bar);
      __builtin_amdgcn_fence(__ATOMIC_ACQUIRE, "agent");
      asm volatile("s_waitcnt vmcnt(0)" ::: "memory");
    }
  }
  __syncthreads();
}

template <int NI>
DI void gemm_main(f32x16 (&acc)[2][NI], const bf16_t* __restrict__ A, int lda, const bf16_t* __restrict__ Bt, int ldb, int K, char* smem) {
  constexpr int BN = 64 * NI;
  constexpr int ABYTES = 128 * 144, STAGE = ABYTES + BN * 144;
  const int tid = tid_(), lane = tid & 63, wave = tid >> 6, wr = wave >> 1, wc = wave & 1;
  const int lr = tid >> 3, lc = tid & 7;
  const bf16_t* ga = A + (size_t)lr * lda + lc * 8;
  const bf16_t* gb = Bt + (size_t)lr * ldb + lc * 8;
  u32x4 ra[4], rb[2 * NI];
  const int nk = K >> 6;
#pragma unroll
  for (int i = 0; i < 4; ++i) ra[i] = *(const u32x4*)(ga + (size_t)(32 * i) * lda);
#pragma unroll
  for (int i = 0; i < 2 * NI; ++i) rb[i] = *(const u32x4*)(gb + (size_t)(32 * i) * ldb);
  {
    char* base = smem;
#pragma unroll
    for (int i = 0; i < 4; ++i) *(u32x4*)(base + (lr + 32 * i) * 144 + lc * 16) = ra[i];
#pragma unroll
    for (int i = 0; i < 2 * NI; ++i) *(u32x4*)(base + ABYTES + (lr + 32 * i) * 144 + lc * 16) = rb[i];
  }
  const int aoff = (wr * 64 + (lane & 31)) * 144 + (lane >> 5) * 16;
  const int boff = ABYTES + (wc * 32 * NI + (lane & 31)) * 144 + (lane >> 5) * 16;
  for (int kt = 0; kt < nk; ++kt) {
    const bool more = (kt + 1 < nk);
    if (more) {
      const int k0 = (kt + 1) * 64;
#pragma unroll
      for (int i = 0; i < 4; ++i) ra[i] = *(const u32x4*)(ga + (size_t)(32 * i) * lda + k0);
#pragma unroll
      for (int i = 0; i < 2 * NI; ++i) rb[i] = *(const u32x4*)(gb + (size_t)(32 * i) * ldb + k0);
    }
    __syncthreads();
    const char* sb = smem + (kt & 1) * STAGE;
#pragma unroll
    for (int ks = 0; ks < 4; ++ks) {
      bf16x8 af[2], bfr[NI];
#pragma unroll
      for (int mi = 0; mi < 2; ++mi) af[mi] = *(const bf16x8*)(sb + aoff + mi * 32 * 144 + ks * 32);
#pragma unroll
      for (int ni = 0; ni < NI; ++ni) bfr[ni] = *(const bf16x8*)(sb + boff + ni * 32 * 144 + ks * 32);
#pragma unroll
      for (int mi = 0; mi < 2; ++mi)
#pragma unroll
        for (int ni = 0; ni < NI; ++ni) acc[mi][ni] = __builtin_amdgcn_mfma_f32_32x32x16_bf16(af[mi], bfr[ni], acc[mi][ni], 0, 0, 0);
    }
    if (more) {
      char* base = smem + ((kt + 1) & 1) * STAGE;
#pragma unroll
      for (int i = 0; i < 4; ++i) *(u32x4*)(base + (lr + 32 * i) * 144 + lc * 16) = ra[i];
#pragma unroll
      for (int i = 0; i < 2 * NI; ++i) *(u32x4*)(base + ABYTES + (lr + 32 * i) * 144 + lc * 16) = rb[i];
    }
  }
  __syncthreads();
}

template <int NI>
DI void zero_acc(f32x16 (&acc)[2][NI]) {
  const f32x16 z = {0.f, 0.f, 0.f, 0.f, 0.f, 0.f, 0.f, 0.f, 0.f, 0.f, 0.f, 0.f, 0.f, 0.f, 0.f, 0.f};
#pragma unroll
  for (int mi = 0; mi < 2; ++mi)
#pragma unroll
    for (int ni = 0; ni < NI; ++ni) acc[mi][ni] = z;
}

DI bool tile_of(int base, int ntm, int ntn, int& pm, int& pn) {
  const int G = gridDim.x, bid = bid_();
  int tl = ((G & 7) == 0) ? (bid & 7) * (G >> 3) + (bid >> 3) : bid;
  int t = base + tl;
  if (t >= ntm * ntn) return false;
  const int per = 16 * ntn;
  int g = t / per, r = t - g * per;
  pm = g * 16 + (r & 15);
  pn = r >> 4;
  return true;
}

template <int NI>
DI void store_bf16_tile(const f32x16 (&acc)[2][NI], bf16_t* C, int ldc) {
  const int lane = tid_() & 63, wave = tid_() >> 6, wr = wave >> 1, wc = wave & 1, odd = lane & 1;
#pragma unroll
  for (int mi = 0; mi < 2; ++mi)
#pragma unroll
    for (int ni = 0; ni < NI; ++ni)
#pragma unroll
      for (int i = 0; i < 16; i += 2) {
        float v0 = acc[mi][ni][i], v1 = acc[mi][ni][i + 1];
        float send = odd ? v0 : v1;
        float recv = dpp_xor1(send);
        int r = wr * 64 + mi * 32 + (i & 3) + 8 * (i >> 2) + 4 * (lane >> 5) + odd;
        int c = wc * 32 * NI + ni * 32 + (lane & 31) - odd;
        unsigned val = odd ? pk2(recv, v1) : pk2(v0, recv);
        *(unsigned*)(C + (size_t)r * ldc + c) = val;
      }
}


DI void gemm_big(f32x16 (&acc)[4][2], const bf16_t* __restrict__ A, int lda, const bf16_t* __restrict__ Bt, const bf16_t* __restrict__ Bt2, int ldb, int K, char* smem) {
  constexpr int ABYTES = 256 * 144;
  const int tid = tid_(), lane = tid & 63, wave = tid >> 6, wr = wave >> 1, wc = wave & 1;
  const int lr = tid >> 3, lc = tid & 7;
  const bf16_t* ga = A + (size_t)lr * lda + lc * 8;
  const bf16_t* gb = Bt + (size_t)lr * ldb + lc * 8;
  const bf16_t* gb2 = Bt2 + (size_t)lr * ldb + lc * 8;
  u32x4 ra[8], rb[4];
  const int nk = K >> 6;
#pragma unroll
  for (int i = 0; i < 8; ++i) ra[i] = *(const u32x4*)(ga + (size_t)(32 * i) * lda);
#pragma unroll
  for (int i = 0; i < 4; ++i) rb[i] = *(const u32x4*)((i < 2 ? gb : gb2) + (size_t)(32 * (i & 1)) * ldb);
  const int aoff = (wr * 128 + (lane & 31)) * 144 + (lane >> 5) * 16;
  const int boff = ABYTES + (wc * 64 + (lane & 31)) * 144 + (lane >> 5) * 16;
  for (int kt = 0; kt < nk; ++kt) {
    __syncthreads();
#pragma unroll
    for (int i = 0; i < 8; ++i) *(u32x4*)(smem + (lr + 32 * i) * 144 + lc * 16) = ra[i];
#pragma unroll
    for (int i = 0; i < 4; ++i) *(u32x4*)(smem + ABYTES + (lr + 32 * i) * 144 + lc * 16) = rb[i];
    __syncthreads();
    if (kt + 1 < nk) {
      const int k0 = (kt + 1) * 64;
#pragma unroll
      for (int i = 0; i < 8; ++i) ra[i] = *(const u32x4*)(ga + (size_t)(32 * i) * lda + k0);
#pragma unroll
      for (int i = 0; i < 4; ++i) rb[i] = *(const u32x4*)((i < 2 ? gb : gb2) + (size_t)(32 * (i & 1)) * ldb + k0);
    }
#pragma unroll
    for (int ks = 0; ks < 4; ++ks) {
      bf16x8 af[4], bfr[2];
#pragma unroll
      for (int mi = 0; mi < 4; ++mi) af[mi] = *(const bf16x8*)(smem + aoff + mi * 32 * 144 + ks * 32);
#pragma unroll
      for (int ni = 0; ni < 2; ++ni) bfr[ni] = *(const bf16x8*)(smem + boff + ni * 32 * 144 + ks * 32);
#pragma unroll
      for (int mi = 0; mi < 4; ++mi)
#pragma unroll
        for (int ni = 0; ni < 2; ++ni) acc[mi][ni] = __builtin_amdgcn_mfma_f32_32x32x16_bf16(af[mi], bfr[ni], acc[mi][ni], 0, 0, 0);
    }
  }
  __syncthreads();
}
DI void store_bf16_big(const f32x16 (&acc)[4][2], bf16_t* C, int ldc) {
  const int lane = tid_() & 63, wave = tid_() >> 6, wr = wave >> 1, wc = wave & 1, odd = lane & 1;
#pragma unroll
  for (int mi = 0; mi < 4; ++mi)
#pragma unroll
    for (int ni = 0; ni < 2; ++ni)
#pragma unroll
      for (int i = 0; i < 16; i += 2) {
        float v0 = acc[mi][ni][i], v1 = acc[mi][ni][i + 1];
        float send = odd ? v0 : v1;
        float recv = dpp_xor1(send);
        int r = wr * 128 + mi * 32 + (i & 3) + 8 * (i >> 2) + 4 * (lane >> 5) + odd;
        int c = wc * 64 + ni * 32 + (lane & 31) - odd;
        unsigned val = odd ? pk2(recv, v1) : pk2(v0, recv);
        *(unsigned*)(C + (size_t)r * ldc + c) = val;
      }
}
DI bool tile_of8(int base, int ntm, int ntn, int& pm, int& pn) {
  const int G = gridDim.x, bid = bid_();
  int tl = ((G & 7) == 0) ? (bid & 7) * (G >> 3) + (bid >> 3) : bid;
  int t = base + tl;
  if (t >= ntm * ntn) return false;
  const int per = 8 * ntn;
  int g = t / per, r = t - g * per;
  pm = g * 8 + (r & 7);
  pn = r >> 3;
  return true;
}

DI int win_map(int n) { return n < 1536 ? n : (n < 4352 ? n + 16 : (n < 4368 ? n - 4352 + 1536 : (n < 4384 ? n : -1))); }
DI void convert_tile(const float* __restrict__ src, int ldsrc, int mode, bf16_t* __restrict__ dst, int K, int nt, int kt, char* smem) {
  float* tile = (float*)smem;
  const int tid = tid_();
  const int n0 = nt * 64, k0 = kt * 64, tn = tid & 63, tk = tid >> 6;
  const int n = n0 + tn;
  const int on = mode ? win_map(n) : n;
#pragma unroll 4
  for (int i = 0; i < 16; ++i) {
    int k = tk + 4 * i;
    tile[k * 65 + tn] = on >= 0 ? src[(size_t)(k0 + k) * ldsrc + on] : 0.f;
  }
  __syncthreads();
  const int wn = tid >> 2, kq = tid & 3;
  unsigned o[8];
#pragma unroll
  for (int j = 0; j < 8; ++j) o[j] = pk2(tile[(kq * 16 + 2 * j) * 65 + wn], tile[(kq * 16 + 2 * j + 1) * 65 + wn]);
  u32x4* d = (u32x4*)(dst + (size_t)(n0 + wn) * K + k0 + kq * 16);
  d[0] = mk4(o[0], o[1], o[2], o[3]);
  d[1] = mk4(o[4], o[5], o[6], o[7]);
  __syncthreads();
}
DI void convert_weights(const Params& p, int l, char* smem) {
  bf16_t* wbf = (bf16_t*)(p.ws + OFF_WBF);
  for (int t = bid_(); t < 4640; t += gridDim.x) {
    if (t < 1120) convert_tile(p.w_in + (size_t)l * 1024 * INC, INC, 1, wbf + W_IN, 1024, t >> 4, t & 15, smem);
    else if (t < 1888) { int tt = t - 1120; convert_tile(p.w_in + (size_t)l * 1024 * INC + 4384, INC, 0, wbf + W_G, 1024, tt >> 4, tt & 15, smem); }
    else if (t < 2272) { int tt = t - 1888; int br = tt >> 7, rem = tt & 127;
      convert_tile(p.w_branch + (size_t)(l * 3 + br) * 512 * 1024, 1024, 0, wbf + W_B + (size_t)br * 1024 * 512, 512, rem >> 3, rem & 7, smem); }
    else if (t < 2528) { int tt = t - 2272; convert_tile(p.w_out + (size_t)l * 1024 * 1024, 1024, 0, wbf + W_O, 1024, tt >> 4, tt & 15, smem); }
    else if (t < 3936) { int tt = t - 2528; convert_tile(p.w_up + (size_t)l * 1024 * 5632, 5632, 0, wbf + W_UP, 1024, tt >> 4, tt & 15, smem); }
    else { int tt = t - 3936; convert_tile(p.w_down + (size_t)l * DFF * 1024, 1024, 0, wbf + W_DN, DFF, tt / 44, tt % 44, smem); }
  }
}

DI void ada_partial(const Params& p, int item, char* smem) {
  float* sv = (float*)smem;
  const int tid = tid_();
  const int kc = item & 15, cc = (item >> 4) % 6, l = item / 96;
  const int k0 = kc * 64;
  __syncthreads();
  for (int i = tid; i < 576; i += 256) {
    int r = i >> 6, kk = i & 63;
    float v = r < 8 ? p.c[r * 1024 + k0 + kk] : p.c_ctx[k0 + kk];
    sv[i] = siluf_(v);
  }
  __syncthreads();
  const int col = cc * 1024 + tid * 4;
  float4 acc[9];
#pragma unroll
  for (int r = 0; r < 9; ++r) acc[r] = make_float4(0.f, 0.f, 0.f, 0.f);
  const float* w = p.ada_w + ((size_t)l * 1024 + k0) * 6144 + col;
#pragma unroll 4
  for (int kk = 0; kk < 64; ++kk) {
    float4 wv = *(const float4*)(w + (size_t)kk * 6144);
#pragma unroll
    for (int r = 0; r < 9; ++r) {
      float s = sv[r * 64 + kk];
      acc[r].x += s * wv.x; acc[r].y += s * wv.y; acc[r].z += s * wv.z; acc[r].w += s * wv.w;
    }
  }
  float* part = (float*)(p.ws + OFF_ACT);
#pragma unroll
  for (int r = 0; r < 9; ++r) *(float4*)(part + ((size_t)(l * 16 + kc) * 9 + r) * 6144 + col) = acc[r];
}

DI void norm_phase(const Params& p, int l, int which, bool skip_ctx) {
  const float* nw = (which ? p.norm2_w : p.norm1_w) + l * 1024;
  const float* modl = (const float*)(p.ws + OFF_MOD) + (size_t)l * 9 * 6144;
  bf16_t* xn = (bf16_t*)(p.ws + OFF_XN);
  const int lane = tid_() & 63;
#pragma unroll 2
  for (int row = bid_() * 4 + (tid_() >> 6); row < M; row += gridDim.x * 4) {
    int b = row / TT, t = row - b * TT;
    if (skip_ctx && t < CTX) continue;
    const float* hp = (l == 0 && which == 0) ? (t < CTX ? p.ctx + (size_t)(b * CTX + t) * D : p.x + (size_t)(b * SEQ + t - CTX) * D) : hrow(p, row);
    const float* sh = modl + (t < CTX ? 8 : b) * 6144 + which * 3072;
    const float* sc = sh + 1024;
    float4 v[4];
    float ss = 0.f;
#pragma unroll
    for (int i = 0; i < 4; ++i) {
      v[i] = *(const float4*)(hp + i * 256 + lane * 4);
      ss += v[i].x * v[i].x + v[i].y * v[i].y + v[i].z * v[i].z + v[i].w * v[i].w;
    }
    ss = wsum(ss);
    const float rstd = rsqrtf(ss * (1.f / 1024.f) + 1e-6f);
#pragma unroll
    for (int i = 0; i < 4; ++i) {
      const int col = i * 256 + lane * 4;
      float4 w4 = *(const float4*)(nw + col), s4 = *(const float4*)(sc + col), h4 = *(const float4*)(sh + col);
      float y0 = v[i].x * rstd * w4.x * (1.f + s4.x) + h4.x;
      float y1 = v[i].y * rstd * w4.y * (1.f + s4.y) + h4.y;
      float y2 = v[i].z * rstd * w4.z * (1.f + s4.z) + h4.z;
      float y3 = v[i].w * rstd * w4.w * (1.f + s4.w) + h4.w;
      *(u32x2*)(xn + (size_t)row * 1024 + col) = mk2(pk2(y0, y1), pk2(y2, y3));
    }
  }
}

DI void prep_phase(const Params& p, int l, char* smem) {
  bf16_t* P = (bf16_t*)(p.ws + OFF_BIG);
  bf16_t* cq = (bf16_t*)(p.ws + OFF_ACT);
  const float* rope = (const float*)(p.ws + OFF_ROPE);
  const int tid = tid_(), lane = tid & 63;
  {
    bf16_t* tile = (bf16_t*)smem;
    bf16_t* vt = (bf16_t*)(p.ws + OFF_VT);
    for (int it = bid_(); it < 288; it += gridDim.x) {
      int b = it / 36, t0 = (it - b * 36) * 64;
      __syncthreads();
#pragma unroll
      for (int i = 0; i < 4; ++i) {
        int cid = tid + 256 * i, j = cid >> 4, ec = cid & 15;
        u32x4 v = *(const u32x4*)(P + (size_t)(b * TT + t0 + j) * PLD + P_BV + ec * 8);
        *(u32x4*)(tile + j * 136 + ec * 8) = v;
      }
      __syncthreads();
#pragma unroll
      for (int i = 0; i < 4; ++i) {
        int cid = tid + 256 * i, e = cid >> 3, jc = cid & 7;
        unsigned o[4];
#pragma unroll
        for (int jj = 0; jj < 4; ++jj) o[jj] = (unsigned)tile[(jc * 8 + 2 * jj) * 136 + e] | ((unsigned)tile[(jc * 8 + 2 * jj + 1) * 136 + e] << 16);
        *(u32x4*)(vt + ((size_t)b * 128 + e) * TT + t0 + jc * 8) = mk4(o[0], o[1], o[2], o[3]);
      }
    }
  }
  {
    const float* gates = (const float*)(p.ws + OFF_GATES);
    float* aux = (float*)(p.ws + OFF_AUX);
    for (int it = bid_() * 4 + (tid >> 6); it < NB * 36 * 8; it += gridDim.x * 4) {
      const int hd = it & 7, dir = hd >> 2, hh = hd & 3, cb = it >> 3;
      const int b = cb / 36, c = cb - b * 36;
      const size_t row = (size_t)b * TT + c * 64 + (dir ? 63 - lane : lane);
      const float ig = gates[row * 32 + dir * 8 + hh], lf = gates[row * 32 + dir * 8 + 4 + hh], gg = gates[row * 32 + 16 + dir * 4 + hh];
      float bc = lf, gc = gg;
#pragma unroll
      for (int o = 1; o < 64; o <<= 1) {
        float t1 = __shfl_up(bc, o), t2 = __shfl_up(gc, o);
        if (lane >= o) { bc += t1; gc += t2; }
      }
      const float u = ig - bc;
      float gm = u;
#pragma unroll
      for (int o = 1; o < 64; o <<= 1) {
        float t1 = __shfl_up(gm, o);
        if (lane >= o) gm = fmaxf(gm, t1);
      }
      float* ar = aux + row * 32;
      ar[(dir * 4 + hh) * 3 + 0] = bc; ar[(dir * 4 + hh) * 3 + 1] = u; ar[(dir * 4 + hh) * 3 + 2] = gm;
      ar[24 + dir * 4 + hh] = gc;
    }
  }
  {
    const float* qnw = p.b_qnorm_w + l * 64;
    const float* knw = p.b_knorm_w + l * 64;
    const int total = M * 40;
#pragma unroll 2
    for (int idx = bid_() * 256 + tid; idx < total; idx += gridDim.x * 256) {
      const int row = idx / 40, r40 = idx - row * 40, hd = r40 >> 2, sub = r40 & 3, a = sub >> 1, f0 = (sub & 1) * 8;
      const int t = row % TT;
      const bool isq = hd < 8;
      bf16_t* base = P + (size_t)row * PLD + (isq ? P_BQ + hd * 64 : P_BK + (hd - 8) * 64) + a * 32 + f0;
      const u32x4 u1 = *(const u32x4*)base, u2 = *(const u32x4*)(base + 16);
      float x1[8], x2[8];
      unpack8(u1, x1); unpack8(u2, x2);
      float ss = 0.f;
#pragma unroll
      for (int e = 0; e < 8; ++e) ss += x1[e] * x1[e] + x2[e] * x2[e];
      ss += dpp_xor1(ss);
      ss += dpp_xor2(ss);
      const float rstd = rsqrtf(ss * (1.f / 64.f) + 1e-6f);
      const float* nwp = (isq ? qnw : knw) + a * 32 + f0;
      const float osc = isq ? 0.125f * 1.4426950408889634f : 1.f;
      const bool lat = t >= CTX;
      const int tl = t - CTX;
      const int pos = lat ? (a == 0 ? (tl >> 6) : (tl & 63)) : 0;
      float o1[8], o2[8];
#pragma unroll
      for (int e = 0; e < 8; ++e) {
        const float y1 = x1[e] * rstd * nwp[e], y2 = x2[e] * rstd * nwp[16 + e];
        const float cs = lat ? rope[pos * 16 + f0 + e] : 1.f, sn = lat ? rope[1024 + pos * 16 + f0 + e] : 0.f;
        o1[e] = (y1 * cs - y2 * sn) * osc;
        o2[e] = (y2 * cs + y1 * sn) * osc;
      }
      *(u32x4*)base = mk4(pk2(o1[0], o1[1]), pk2(o1[2], o1[3]), pk2(o1[4], o1[5]), pk2(o1[6], o1[7]));
      *(u32x4*)(base + 16) = mk4(pk2(o2[0], o2[1]), pk2(o2[2], o2[3]), pk2(o2[4], o2[5]), pk2(o2[6], o2[7]));
    }
  }
  {
    const float* cw = p.c_conv_w + (size_t)l * 3 * 1536;
    const int total = (M / 16) * 192;
    for (int idx = bid_() * 256 + tid; idx < total; idx += gridDim.x * 256) {
      const int grp = idx / 192, ck = idx - grp * 192, ch = ck * 8, ph = ck >> 4;
      const int row0 = grp * 16, t0 = row0 % TT;
      float w0[8], w1[8], w2[8];
#pragma unroll
      for (int q = 0; q < 2; ++q) {
        const float4 a = *(const float4*)(cw + ch + 4 * q), bq = *(const float4*)(cw + 1536 + ch + 4 * q), c4 = *(const float4*)(cw + 3072 + ch + 4 * q);
        w0[4 * q] = a.x; w0[4 * q + 1] = a.y; w0[4 * q + 2] = a.z; w0[4 * q + 3] = a.w;
        w1[4 * q] = bq.x; w1[4 * q + 1] = bq.y; w1[4 * q + 2] = bq.z; w1[4 * q + 3] = bq.w;
        w2[4 * q] = c4.x; w2[4 * q + 1] = c4.y; w2[4 * q + 2] = c4.z; w2[4 * q + 3] = c4.w;
      }
      const bf16_t* pr = P + (size_t)row0 * PLD + P_CQ + ch;
      const u32x4 z = mk4(0u, 0u, 0u, 0u);
      const bool hp = (t0 != 0 && t0 != CTX), hn = (t0 + 15 != CTX - 1 && t0 + 15 != TT - 1);
      u32x4 up = hp ? *(const u32x4*)(pr - PLD) : z;
      u32x4 uc = *(const u32x4*)pr;
      const float nsc = ph < 4 ? 0.08838834764831845f : 1.f;
#pragma unroll 4
      for (int rr = 0; rr < 16; ++rr) {
        const bool has = rr < 15 || hn;
        const u32x4 un = has ? *(const u32x4*)(pr + (size_t)(rr + 1) * PLD) : z;
        float fc[8], fp[8], fn[8], y[8];
        unpack8(uc, fc); unpack8(up, fp); unpack8(un, fn);
        float ss = 0.f;
#pragma unroll
        for (int e = 0; e < 8; ++e) { y[e] = siluf_(w0[e] * fp[e] + w1[e] * fc[e] + w2[e] * fn[e]); ss += y[e] * y[e]; }
        ss += dpp_xor1(ss);
        ss += dpp_xor2(ss);
        ss += __shfl_xor(ss, 4);
        ss += __shfl_xor(ss, 8);
        const float sc = ph < 8 ? rsqrtf(ss + 1e-6f) * nsc : 1.f;
        *(u32x4*)(cq + (size_t)(row0 + rr) * 1536 + ch) = mk4(pk2(y[0] * sc, y[1] * sc), pk2(y[2] * sc, y[3] * sc), pk2(y[4] * sc, y[5] * sc), pk2(y[6] * sc, y[7] * sc));
        up = uc; uc = un;
      }
    }
  }
}

DI void attn_item(const Params& p, int item, char* smem) {
  const bf16_t* P = (const bf16_t*)(p.ws + OFF_BIG);
  const bf16_t* vt = (const bf16_t*)(p.ws + OFF_VT);
  bf16_t* Y = (bf16_t*)(p.ws + OFF_Y);
  const int tid = tid_(), lane = tid & 63, wave = tid >> 6, h = lane >> 5, l31 = lane & 31;
  int b, head, qrow0, nkeys;
  if (item < 1024) { b = item >> 7; head = (item >> 4) & 7; qrow0 = b * TT + CTX + (item & 15) * 128; nkeys = TT; }
  else { int it = item - 1024; b = it >> 4; head = (it >> 1) & 7; qrow0 = b * TT + (it & 1) * 128; nkeys = CTX; }
  const int kvh = head >> 2;
  const int qrow = qrow0 + wave * 32 + l31;
  bf16x8 qf[4];
#pragma unroll
  for (int s = 0; s < 4; ++s) qf[s] = *(const bf16x8*)(P + (size_t)qrow * PLD + P_BQ + head * 64 + s * 16 + 8 * h);
  f32x16 O[2];
#pragma unroll
  for (int i = 0; i < 16; ++i) { O[0][i] = 0.f; O[1][i] = 0.f; }
  float m = -1e30f, lsum = 0.f;
  constexpr int KVB = 64 * 144 + 64 * 136;
  const bf16_t* kbase = P + (size_t)(b * TT) * PLD + P_BK + kvh * 64;
  const bf16_t* vbase = vt + (size_t)(b * 2 + kvh) * 64 * TT;
  u32x4 kr[2], vr[2];
  const int ntiles = nkeys >> 6;
  auto kvload = [&](int key0) {
#pragma unroll
    for (int i = 0; i < 2; ++i) {
      int cid = tid + 256 * i, r = cid >> 3, cc = cid & 7;
      kr[i] = *(const u32x4*)(kbase + (size_t)(key0 + r) * PLD + cc * 8);
      vr[i] = *(const u32x4*)(vbase + (size_t)r * TT + key0 + cc * 8);
    }
  };
  auto kvwrite = [&](int buf) {
    char* bK = smem + buf * KVB;
    char* bV = bK + 64 * 144;
#pragma unroll
    for (int i = 0; i < 2; ++i) {
      int cid = tid + 256 * i, r = cid >> 3, cc = cid & 7;
      *(u32x4*)(bK + r * 144 + cc * 16) = kr[i];
      *(u32x2*)(bV + r * 136 + cc * 16) = mk2(vr[i].x, vr[i].y);
      *(u32x2*)(bV + r * 136 + cc * 16 + 8) = mk2(vr[i].z, vr[i].w);
    }
  };
  kvload(0);
  __syncthreads();
  kvwrite(0);
  if (ntiles > 1) kvload(64);
  __syncthreads();
  for (int kt = 0; kt < ntiles; ++kt) {
    const char* sK = smem + (kt & 1) * KVB;
    const char* sV = sK + 64 * 144;
    if (kt + 1 < ntiles) {
      kvwrite((kt + 1) & 1);
      if (kt + 2 < ntiles) kvload((kt + 2) * 64);
    }
    f32x16 X[2];
#pragma unroll
    for (int k2 = 0; k2 < 2; ++k2) {
#pragma unroll
      for (int i = 0; i < 16; ++i) X[k2][i] = 0.f;
#pragma unroll
      for (int s = 0; s < 4; ++s) {
        bf16x8 kf = *(const bf16x8*)(sK + (k2 * 32 + l31) * 144 + s * 32 + h * 16);
        X[k2] = __builtin_amdgcn_mfma_f32_32x32x16_bf16(kf, qf[s], X[k2], 0, 0, 0);
      }
    }
    float mx = X[0][0];
#pragma unroll
    for (int i = 0; i < 16; ++i) { mx = fmaxf(mx, X[0][i]); mx = fmaxf(mx, X[1][i]); }
    mx = fmaxf(mx, __shfl_xor(mx, 32));
    const float mnew = fmaxf(m, mx);
    const float alpha = __builtin_amdgcn_exp2f(m - mnew);
    m = mnew;
    float ps = 0.f;
#pragma unroll
    for (int k2 = 0; k2 < 2; ++k2)
#pragma unroll
      for (int i = 0; i < 16; ++i) { float e = __builtin_amdgcn_exp2f(X[k2][i] - mnew); X[k2][i] = e; ps += e; }
    lsum = lsum * alpha + ps;
#pragma unroll
    for (int i = 0; i < 16; ++i) { O[0][i] *= alpha; O[1][i] *= alpha; }
#pragma unroll
    for (int k2 = 0; k2 < 2; ++k2)
#pragma unroll
      for (int s2 = 0; s2 < 2; ++s2) {
        u32x4 pu = mk4(pk2(X[k2][8 * s2 + 0], X[k2][8 * s2 + 1]), pk2(X[k2][8 * s2 + 2], X[k2][8 * s2 + 3]),
                              pk2(X[k2][8 * s2 + 4], X[k2][8 * s2 + 5]), pk2(X[k2][8 * s2 + 6], X[k2][8 * s2 + 7]));
        bf16x8 pf = __builtin_bit_cast(bf16x8, pu);
#pragma unroll
        for (int dt = 0; dt < 2; ++dt) {
          const char* va = sV + (dt * 32 + l31) * 136 + (k2 * 32 + 16 * s2 + 4 * h) * 2;
          u32x2 v0 = *(const u32x2*)va, v1 = *(const u32x2*)(va + 16);
          bf16x8 vf = __builtin_bit_cast(bf16x8, mk4(v0.x, v0.y, v1.x, v1.y));
          O[dt] = __builtin_amdgcn_mfma_f32_32x32x16_bf16(vf, pf, O[dt], 0, 0, 0);
        }
      }
    __syncthreads();
  }
  lsum += __shfl_xor(lsum, 32);
  const float inv = 1.f / lsum;
  bf16_t* yr = Y + (size_t)qrow * 1536 + 512 + head * 64;
#pragma unroll
  for (int dt = 0; dt < 2; ++dt)
#pragma unroll
    for (int g = 0; g < 4; ++g) {
      const int d = dt * 32 + 8 * g + 4 * h;
      *(u32x2*)(yr + d) = mk2(pk2(O[dt][4 * g] * inv, O[dt][4 * g + 1] * inv), pk2(O[dt][4 * g + 2] * inv, O[dt][4 * g + 3] * inv));
    }
}

DI void mlstm_chunk_item(const Params& p, int item, char* smem) {
  const bf16_t* P = (const bf16_t*)(p.ws + OFF_BIG);
  const float* aux = (const float*)(p.ws + OFF_AUX);
  const int tid = tid_(), lane = tid & 63, w = tid >> 6, h = lane >> 5, l31 = lane & 31;
  const int dir = item & 1, hh = (item >> 1) & 3, b = item >> 3;
  bf16_t* ob = (bf16_t*)(p.ws + OFF_HSA) + (size_t)dir * M * 512;
  char* sQ = smem; char* sK = smem + 9216; char* sKt = smem + 18432; char* sVt = smem + 27648;
  float* sbc = (float*)(smem + 46080); float* su = sbc + 64; float* sgm = su + 64; float* sn = sgm + 64;
  const f32x16 z16 = {0.f, 0.f, 0.f, 0.f, 0.f, 0.f, 0.f, 0.f, 0.f, 0.f, 0.f, 0.f, 0.f, 0.f, 0.f, 0.f};
  f32x16 C0 = z16, C1 = z16;
  float m = -1e30f;
  __syncthreads();
  if (tid < 64) sn[tid] = 0.f;
  u32x4 rq[2], rk[2], rv[4];
  float ru = 0.f, rg63 = 0.f, ra0 = 0.f, ra1 = 0.f, ra2 = 0.f;
  const int aoff = (dir * 4 + hh) * 3;
  auto gload = [&](int k) {
    const int c = dir ? (k < 4 ? 3 - k : 39 - k) : k;
    const size_t row0 = (size_t)b * TT + c * 64;
    const int j = tid & 63, c0 = tid >> 6;
    const bf16_t* pr = P + (row0 + j) * PLD;
#pragma unroll
    for (int i = 0; i < 2; ++i) {
      rq[i] = *(const u32x4*)(pr + P_AQ + hh * 64 + (c0 + 4 * i) * 8);
      rk[i] = *(const u32x4*)(pr + P_AK + hh * 64 + (c0 + 4 * i) * 8);
    }
#pragma unroll
    for (int i = 0; i < 4; ++i) rv[i] = *(const u32x4*)(pr + P_AV + hh * 128 + (c0 + 4 * i) * 8);
    ru = aux[(row0 + j) * 32 + aoff + 1];
    rg63 = aux[(row0 + (dir ? 0 : 63)) * 32 + aoff + 2];
    if (tid < 64) {
      const float* ar = aux + (row0 + (dir ? 63 - tid : tid)) * 32 + aoff;
      ra0 = ar[0]; ra1 = ar[1]; ra2 = ar[2];
    }
  };
  gload(0);
#pragma unroll 1
  for (int k = 0; k < 36; ++k) {
    const int c = dir ? (k < 4 ? 3 - k : 39 - k) : k;
    const size_t row0 = (size_t)b * TT + c * 64;
    __syncthreads();
    {
      const int j = tid & 63, pp = dir ? 63 - j : j, c0 = tid >> 6;
      const float ksc = __expf(ru - rg63);
      float f[8];
#pragma unroll
      for (int i = 0; i < 2; ++i) {
        const int cc = c0 + 4 * i;
        unpack8(rq[i], f);
        *(u32x4*)(sQ + pp * 144 + cc * 16) = mk4(pk2(f[0] * 0.125f, f[1] * 0.125f), pk2(f[2] * 0.125f, f[3] * 0.125f), pk2(f[4] * 0.125f, f[5] * 0.125f), pk2(f[6] * 0.125f, f[7] * 0.125f));
        *(u32x4*)(sK + pp * 144 + cc * 16) = rk[i];
        unpack8(rk[i], f);
#pragma unroll
        for (int x = 0; x < 8; ++x) *(bf16_t*)(sKt + (cc * 8 + x) * 144 + pp * 2) = f2bf(f[x] * ksc);
      }
#pragma unroll
      for (int i = 0; i < 4; ++i) {
        const int cc = c0 + 4 * i;
        const unsigned wv[4] = {rv[i].x, rv[i].y, rv[i].z, rv[i].w};
#pragma unroll
        for (int x = 0; x < 4; ++x) {
          *(bf16_t*)(sVt + (cc * 8 + 2 * x) * 144 + pp * 2) = (bf16_t)(wv[x] & 0xffffu);
          *(bf16_t*)(sVt + (cc * 8 + 2 * x + 1) * 144 + pp * 2) = (bf16_t)(wv[x] >> 16);
        }
      }
      if (tid < 64) { sbc[tid] = ra0; su[tid] = ra1; sgm[tid] = ra2; }
    }
    __syncthreads();
    if (k + 1 < 36) gload(k + 1);
#pragma unroll 1
    for (int tt = 0; tt < 2; ++tt) {
      const float gmt = sgm[tt * 32 + l31], bct = sbc[tt * 32 + l31];
      float den1 = 0.f;
      f32x16 O1 = z16;
#pragma unroll
      for (int st = 0; st <= tt; ++st) {
        f32x16 X = z16;
#pragma unroll
        for (int ks = 0; ks < 4; ++ks) {
          bf16x8 af = *(const bf16x8*)(sK + (st * 32 + l31) * 144 + ks * 32 + h * 16);
          bf16x8 bq = *(const bf16x8*)(sQ + (tt * 32 + l31) * 144 + ks * 32 + h * 16);
          X = __builtin_amdgcn_mfma_f32_32x32x16_bf16(af, bq, X, 0, 0, 0);
        }
#pragma unroll
        for (int i = 0; i < 16; ++i) {
          const int sl = (i & 3) + 8 * (i >> 2) + 4 * h;
          const float e = __expf(su[st * 32 + sl] - gmt);
          const bool ok = (st < tt) || (sl <= l31);
          const float v = ok ? X[i] * e : 0.f;
          X[i] = v;
          den1 += v;
        }
#pragma unroll
        for (int s2 = 0; s2 < 2; ++s2) {
          bf16x8 pf = __builtin_bit_cast(bf16x8, mk4(pk2(X[8 * s2], X[8 * s2 + 1]), pk2(X[8 * s2 + 2], X[8 * s2 + 3]), pk2(X[8 * s2 + 4], X[8 * s2 + 5]), pk2(X[8 * s2 + 6], X[8 * s2 + 7])));
          const char* va = sVt + (32 * w + l31) * 144 + (st * 32 + 16 * s2 + 4 * h) * 2;
          u32x2 v0 = *(const u32x2*)va, v1 = *(const u32x2*)(va + 16);
          bf16x8 vf = __builtin_bit_cast(bf16x8, mk4(v0.x, v0.y, v1.x, v1.y));
          O1 = __builtin_amdgcn_mfma_f32_32x32x16_bf16(vf, pf, O1, 0, 0, 0);
        }
      }
      __builtin_amdgcn_sched_barrier(0);
      f32x16 O2 = z16;
#pragma unroll
      for (int dt = 0; dt < 2; ++dt)
#pragma unroll
        for (int s2 = 0; s2 < 2; ++s2) {
          bf16x8 cf;
          if (dt == 0) cf = __builtin_bit_cast(bf16x8, mk4(pk2(C0[8 * s2], C0[8 * s2 + 1]), pk2(C0[8 * s2 + 2], C0[8 * s2 + 3]), pk2(C0[8 * s2 + 4], C0[8 * s2 + 5]), pk2(C0[8 * s2 + 6], C0[8 * s2 + 7])));
          else cf = __builtin_bit_cast(bf16x8, mk4(pk2(C1[8 * s2], C1[8 * s2 + 1]), pk2(C1[8 * s2 + 2], C1[8 * s2 + 3]), pk2(C1[8 * s2 + 4], C1[8 * s2 + 5]), pk2(C1[8 * s2 + 6], C1[8 * s2 + 7])));
          const char* qa = sQ + (tt * 32 + l31) * 144 + (dt * 32 + 16 * s2 + 4 * h) * 2;
          u32x2 q0 = *(const u32x2*)qa, q1 = *(const u32x2*)(qa + 16);
          bf16x8 qf = __builtin_bit_cast(bf16x8, mk4(q0.x, q0.y, q1.x, q1.y));
          O2 = __builtin_amdgcn_mfma_f32_32x32x16_bf16(cf, qf, O2, 0, 0, 0);
        }
      __builtin_amdgcn_sched_barrier(0);
      float acc = 0.f;
#pragma unroll
      for (int q4 = 0; q4 < 4; ++q4) {
        u32x4 qv = *(const u32x4*)(sQ + (tt * 32 + l31) * 144 + (32 * h + 8 * q4) * 2);
        float f[8];
        unpack8(qv, f);
        float4 n0 = *(const float4*)(sn + 32 * h + 8 * q4), n1 = *(const float4*)(sn + 32 * h + 8 * q4 + 4);
        acc += f[0] * n0.x + f[1] * n0.y + f[2] * n0.z + f[3] * n0.w + f[4] * n1.x + f[5] * n1.y + f[6] * n1.z + f[7] * n1.w;
      }
      const float den2 = acc + __shfl_xor(acc, 32);
      den1 += __shfl_xor(den1, 32);
      const float mx = fmaxf(m, gmt);
      const float fa = __expf(gmt - mx), fb = __expf(m - mx);
      const float den = fa * den1 + fb * den2;
      const float inv = 1.f / fmaxf(fabsf(den), __expf(-(bct + mx)));
      const float fai = fa * inv, fbi = fb * inv;
      const int pp = tt * 32 + l31, j = dir ? 63 - pp : pp;
      bf16_t* orow = ob + (row0 + j) * 512 + hh * 128 + 32 * w + 4 * h;
#pragma unroll
      for (int g = 0; g < 4; ++g) {
        const float v0 = fai * O1[4 * g] + fbi * O2[4 * g], v1 = fai * O1[4 * g + 1] + fbi * O2[4 * g + 1];
        const float v2 = fai * O1[4 * g + 2] + fbi * O2[4 * g + 2], v3 = fai * O1[4 * g + 3] + fbi * O2[4 * g + 3];
        *(u32x2*)(orow + 8 * g) = mk2(pk2(v0, v1), pk2(v2, v3));
      }
    }
    __builtin_amdgcn_sched_barrier(0);
    const float gm63 = sgm[63], bc63 = sbc[63];
    const float mx63 = fmaxf(m, gm63);
    const float dcy = __expf(m - mx63), fs = __expf(gm63 - mx63);
#pragma unroll
    for (int dt = 0; dt < 2; ++dt) {
      f32x16 Cn = z16;
#pragma unroll
      for (int ss = 0; ss < 4; ++ss) {
        bf16x8 ka = *(const bf16x8*)(sKt + (dt * 32 + l31) * 144 + ss * 32 + h * 16);
        bf16x8 vb = *(const bf16x8*)(sVt + (32 * w + l31) * 144 + ss * 32 + h * 16);
        Cn = __builtin_amdgcn_mfma_f32_32x32x16_bf16(ka, vb, Cn, 0, 0, 0);
      }
      if (dt == 0) C0 = C0 * dcy + Cn * fs; else C1 = C1 * dcy + Cn * fs;
    }
    __syncthreads();
    if (tid < 64) {
      float acc = 0.f;
#pragma unroll
      for (int q8 = 0; q8 < 8; ++q8) {
        u32x4 kv = *(const u32x4*)(sKt + tid * 144 + q8 * 16);
        float f[8];
        unpack8(kv, f);
        acc += ((f[0] + f[1]) + (f[2] + f[3])) + ((f[4] + f[5]) + (f[6] + f[7]));
      }
      sn[tid] = dcy * sn[tid] + fs * acc;
    }
    m = bc63 + mx63;
  }
  __syncthreads();
}


DI void gdn_pre_item(const Params& p, int item, char* smem) {
  const bf16_t* cq = (const bf16_t*)(p.ws + OFF_ACT);
  const float* aux = (const float*)(p.ws + OFF_AUX);
  const float* gates = (const float*)(p.ws + OFF_GATES);
  bf16_t* P = (bf16_t*)(p.ws + OFF_BIG);
  bf16_t* Y = (bf16_t*)(p.ws + OFF_Y);
  const int tid = tid_(), lane = tid & 63, w = tid >> 6, h = lane >> 5, l31 = lane & 31;
  const int dir = item & 1, hh = (item >> 1) & 3, cb = item >> 3;
  const int b = cb / 36, c = cb - b * 36;
  const size_t row0 = (size_t)b * TT + c * 64;
  char* sK = smem; char* sQ = smem + 17408; char* sV = smem + 34816;
  float* sA = (float*)(smem + 52224);
  float* sG = (float*)(smem + 69632); float* sB = sG + 64;
  __syncthreads();
  {
    const int j = tid & 63, pp = dir ? 63 - j : j, c0 = tid >> 6;
    const bf16_t* src = cq + (row0 + j) * 1536 + hh * 128;
#pragma unroll 2
    for (int i = 0; i < 4; ++i) {
      const int cc = c0 + 4 * i;
      *(u32x4*)(sQ + pp * 272 + cc * 16) = *(const u32x4*)(src + cc * 8);
      *(u32x4*)(sK + pp * 272 + cc * 16) = *(const u32x4*)(src + 512 + cc * 8);
      *(u32x4*)(sV + pp * 272 + cc * 16) = *(const u32x4*)(src + 1024 + cc * 8);
    }
    if (tid < 64) {
      const size_t r = row0 + (dir ? 63 - tid : tid);
      sG[tid] = aux[r * 32 + 24 + dir * 4 + hh];
      sB[tid] = gates[r * 32 + 24 + dir * 4 + hh];
    }
  }
  __syncthreads();
#pragma unroll 1
  for (int job = w; job < 6; job += 4) {
    const int isq = job >= 3, tl = isq ? job - 3 : job;
    const int rt = tl == 0 ? 0 : 1, ct = tl == 2 ? 1 : 0;
    const char* abase = (isq ? sQ : sK) + (rt * 32 + l31) * 272 + h * 16;
    const char* bbase = sK + (ct * 32 + l31) * 272 + h * 16;
    f32x16 X = {0.f, 0.f, 0.f, 0.f, 0.f, 0.f, 0.f, 0.f, 0.f, 0.f, 0.f, 0.f, 0.f, 0.f, 0.f, 0.f};
#pragma unroll
    for (int ks = 0; ks < 8; ++ks) {
      bf16x8 af = *(const bf16x8*)(abase + ks * 32), bfr = *(const bf16x8*)(bbase + ks * 32);
      X = __builtin_amdgcn_mfma_f32_32x32x16_bf16(af, bfr, X, 0, 0, 0);
    }
    const int cidx = ct * 32 + l31;
    const float gc = sG[cidx];
#pragma unroll
    for (int i = 0; i < 16; ++i) {
      const int rl = (i & 3) + 8 * (i >> 2) + 4 * h, r = rt * 32 + rl;
      const float gr = sG[r];
      if (!isq) {
        const bool ok = (rt > ct) || (l31 < rl);
        sA[r * 68 + cidx] = ok ? X[i] * __expf(gr - gc) * sB[r] : 0.f;
      } else {
        const bool ok = (rt > ct) || (l31 <= rl);
        const float v = ok ? X[i] * __expf(gr - gc) : 0.f;
        Y[(row0 + (dir ? 63 - r : r)) * 1536 + 1024 + dir * 256 + hh * 64 + cidx] = f2bf(v);
      }
    }
  }
  __syncthreads();
  {
    const int cidx = tid & 127;
    const bool isw = tid >= 128;
    const char* bsrc = (isw ? sK : sV) + cidx * 2;
    float x[64];
#pragma unroll
    for (int t = 0; t < 64; ++t) x[t] = 0.f;
    bf16_t* wp = dir ? Y + (row0 + 63) * 1536 + hh * 128 + cidx : P + row0 * PLD + P_CQ + 1024 + hh * 128 + cidx;
    const long wstep = dir ? -1536 : PLD;
#pragma unroll
    for (int t = 0; t < 64; ++t) {
      const float g = sG[t], be = sB[t];
      float acc = bf2f(*(const bf16_t*)(bsrc + t * 272)) * (isw ? be * __expf(g) : be);
      float acc1 = 0.f, acc2 = 0.f, acc3 = 0.f;
#pragma unroll
      for (int s4 = 0; s4 < (t + 3) / 4; ++s4) {
        const float4 a = *(const float4*)(sA + t * 68 + 4 * s4);
        acc -= a.x * x[4 * s4];
        acc1 -= a.y * x[4 * s4 + 1];
        acc2 -= a.z * x[4 * s4 + 2];
        acc3 -= a.w * x[4 * s4 + 3];
      }
      acc = (acc + acc1) + (acc2 + acc3);
      x[t] = acc;
      __builtin_amdgcn_sched_barrier(0);
      if (isw) *wp = f2bf(-acc);
      wp += wstep;
      asm volatile("" : "+v"(wp));
    }
    if (!isw) {
      bf16_t* ud = P + (row0 + (cidx >> 1)) * PLD + P_CQ + dir * 512 + hh * 128 + (cidx & 1) * 64;
#pragma unroll
      for (int q = 0; q < 8; ++q)
        *(u32x4*)(ud + 8 * q) = mk4(pk2(x[8 * q], x[8 * q + 1]), pk2(x[8 * q + 2], x[8 * q + 3]), pk2(x[8 * q + 4], x[8 * q + 5]), pk2(x[8 * q + 6], x[8 * q + 7]));
    }
  }
}

DI void gdn_chunk_item(const Params& p, int item, char* smem) {
  const bf16_t* cq = (const bf16_t*)(p.ws + OFF_ACT);
  const float* aux = (const float*)(p.ws + OFF_AUX);
  const bf16_t* P = (const bf16_t*)(p.ws + OFF_BIG);
  const bf16_t* Y = (const bf16_t*)(p.ws + OFF_Y);
  const int tid = tid_(), lane = tid & 63, w = tid >> 6, h = lane >> 5, l31 = lane & 31;
  const int dir = item & 1, hh = (item >> 1) & 3, b = item >> 3;
  bf16_t* ob = (bf16_t*)(p.ws + OFF_HSC) + (size_t)dir * M * 512;
  float* sG = (float*)(smem + 65536);
  const f32x16 z16 = {0.f, 0.f, 0.f, 0.f, 0.f, 0.f, 0.f, 0.f, 0.f, 0.f, 0.f, 0.f, 0.f, 0.f, 0.f, 0.f};
  f32x16 S[4] = {z16, z16, z16, z16};
  u32x4 rk[4], rqk[2], uf[4];
  float rg = 0.f;
  const int j = tid & 63, pp = dir ? 63 - j : j, c0 = tid >> 6;
  auto row_of = [&](int k) -> size_t { const int c = dir ? (k < 4 ? 3 - k : 39 - k) : k; return (size_t)b * TT + c * 64; };
  auto dma_qw = [&](int k) {
    const size_t row0 = row_of(k);
    char* base = smem + (k & 1) * 32768;
    int ln = lane;
    asm volatile("" : "+v"(ln));
#pragma unroll
    for (int i = 0; i < 4; ++i) {
      const int grp = w + 4 * i;
      const int rpp = 4 * grp + (ln >> 4), pos = ln & 15;
      const size_t rj = row0 + (dir ? 63 - rpp : rpp);
      const int sc = pos ^ (rpp & 15);
      const bf16_t* qs = cq + rj * 1536 + hh * 128 + sc * 8;
      const bf16_t* ws_ = (dir ? Y + rj * 1536 + hh * 128 : P + rj * PLD + P_CQ + 1024 + hh * 128) + sc * 8;
      __builtin_amdgcn_global_load_lds((const unsigned*)qs, (__attribute__((address_space(3))) unsigned*)(base + grp * 1024), 16, 0, 0);
      __builtin_amdgcn_global_load_lds((const unsigned*)ws_, (__attribute__((address_space(3))) unsigned*)(base + 16384 + grp * 1024), 16, 0, 0);
    }
  };
  auto gload_r = [&](int k) {
    size_t row0 = row_of(k);
    asm volatile("" : "+v"(row0));
    const size_t rj = row0 + j;
#pragma unroll
    for (int i = 0; i < 4; ++i) rk[i] = *(const u32x4*)(cq + rj * 1536 + 512 + hh * 128 + (c0 + 4 * i) * 8);
#pragma unroll
    for (int i = 0; i < 2; ++i) rqk[i] = *(const u32x4*)(Y + rj * 1536 + 1024 + dir * 256 + hh * 64 + (c0 + 4 * i) * 8);
    if (tid < 64) rg = aux[(row0 + (dir ? 63 - tid : tid)) * 32 + 24 + dir * 4 + hh];
    const int e = 32 * w + l31;
    const bf16_t* us = P + (row0 + (e >> 1)) * PLD + P_CQ + dir * 512 + hh * 128 + (e & 1) * 64 + 8 * h;
#pragma unroll
    for (int ks = 0; ks < 4; ++ks) uf[ks] = *(const u32x4*)(us + 16 * ks);
  };
  __syncthreads();
  dma_qw(0);
  gload_r(0);
  if (tid < 64) sG[tid] = rg;
  const int sw16 = (l31 & 15) << 4;
#pragma unroll 1
  for (int k = 0; k < 36; ++k) {
    const size_t row0 = row_of(k);
    char* bufc = smem + (k & 1) * 32768;
    const float* sGc = sG + (k & 1) * 64;
    f32x16 X[2];
#pragma unroll
    for (int st = 0; st < 2; ++st) {
      X[st] = z16;
#pragma unroll
      for (int kk = 0; kk < 2; ++kk) {
        const int j0 = l31 - 16 * kk - 8 * h;
        unsigned idw[4];
#pragma unroll
        for (int q = 0; q < 4; ++q) idw[q] = (j0 == 2 * q) ? 0x00003F80u : ((j0 == 2 * q + 1) ? 0x3F800000u : 0u);
        X[st] = __builtin_amdgcn_mfma_f32_32x32x16_bf16(__builtin_bit_cast(bf16x8, mk4(idw[0], idw[1], idw[2], idw[3])), __builtin_bit_cast(bf16x8, uf[2 * st + kk]), X[st], 0, 0, 0);
      }
    }
    __syncthreads();
    if (k + 1 < 36) dma_qw(k + 1);
    __builtin_amdgcn_sched_barrier(0);
    f32x16 O[2] = {z16, z16};
#pragma unroll
    for (int dq = 0; dq < 4; ++dq)
#pragma unroll
      for (int s2 = 0; s2 < 2; ++s2) {
        const bf16x8 sf = __builtin_bit_cast(bf16x8, mk4(pk2(S[dq][8 * s2], S[dq][8 * s2 + 1]), pk2(S[dq][8 * s2 + 2], S[dq][8 * s2 + 3]),
                                                         pk2(S[dq][8 * s2 + 4], S[dq][8 * s2 + 5]), pk2(S[dq][8 * s2 + 6], S[dq][8 * s2 + 7])));
        const int cb = (4 * dq + 2 * s2) << 4;
        const int o0 = (cb ^ sw16) + 8 * h, o1 = ((cb + 16) ^ sw16) + 8 * h;
#pragma unroll
        for (int st = 0; st < 2; ++st) {
          const char* a = bufc + 16384 + (st * 32 + l31) * 256;
          const u32x2 a0 = *(const u32x2*)(a + o0), a1 = *(const u32x2*)(a + o1);
          X[st] = __builtin_amdgcn_mfma_f32_32x32x16_bf16(__builtin_bit_cast(bf16x8, mk4(a0.x, a0.y, a1.x, a1.y)), sf, X[st], 0, 0, 0);
        }
#pragma unroll
        for (int tt = 0; tt < 2; ++tt) {
          const char* a = bufc + (tt * 32 + l31) * 256;
          const u32x2 a0 = *(const u32x2*)(a + o0), a1 = *(const u32x2*)(a + o1);
          O[tt] = __builtin_amdgcn_mfma_f32_32x32x16_bf16(__builtin_bit_cast(bf16x8, mk4(a0.x, a0.y, a1.x, a1.y)), sf, O[tt], 0, 0, 0);
        }
      }
    __builtin_amdgcn_sched_barrier(0);
#pragma unroll
    for (int tt = 0; tt < 2; ++tt)
#pragma unroll
      for (int i = 0; i < 16; ++i) O[tt][i] *= __expf(sGc[tt * 32 + (i & 3) + 8 * (i >> 2) + 4 * h]);
    asm volatile("s_waitcnt lgkmcnt(0)" ::: "memory");
    __builtin_amdgcn_s_barrier();
    {
      char* sKt = bufc; char* sQK = bufc + 18432;
#pragma unroll
      for (int i = 0; i < 4; ++i) {
        const int cc = c0 + 4 * i;
        const unsigned kw[4] = {rk[i].x, rk[i].y, rk[i].z, rk[i].w};
#pragma unroll
        for (int x = 0; x < 4; ++x) {
          *(bf16_t*)(sKt + (cc * 8 + 2 * x) * 144 + pp * 2) = (bf16_t)(kw[x] & 0xffffu);
          *(bf16_t*)(sKt + (cc * 8 + 2 * x + 1) * 144 + pp * 2) = (bf16_t)(kw[x] >> 16);
        }
      }
#pragma unroll
      for (int i = 0; i < 2; ++i) {
        const int cc = c0 + 4 * i;
        *(u32x2*)(sQK + pp * 136 + cc * 16) = mk2(rqk[i].x, rqk[i].y);
        *(u32x2*)(sQK + pp * 136 + cc * 16 + 8) = mk2(rqk[i].z, rqk[i].w);
      }
    }
    asm volatile("s_waitcnt lgkmcnt(0)" ::: "memory");
    __builtin_amdgcn_s_barrier();
    __builtin_amdgcn_sched_barrier(0);
    {
      const char* sQK = bufc + 18432;
#pragma unroll
      for (int st = 0; st < 2; ++st)
#pragma unroll
        for (int s2 = 0; s2 < 2; ++s2) {
          const bf16x8 vf = __builtin_bit_cast(bf16x8, mk4(pk2(X[st][8 * s2], X[st][8 * s2 + 1]), pk2(X[st][8 * s2 + 2], X[st][8 * s2 + 3]),
                                                           pk2(X[st][8 * s2 + 4], X[st][8 * s2 + 5]), pk2(X[st][8 * s2 + 6], X[st][8 * s2 + 7])));
#pragma unroll
          for (int tt = st; tt < 2; ++tt) {
            const char* a = sQK + (tt * 32 + l31) * 136 + (st * 32 + 16 * s2 + 4 * h) * 2;
            const u32x2 a0 = *(const u32x2*)a, a1 = *(const u32x2*)(a + 16);
            O[tt] = __builtin_amdgcn_mfma_f32_32x32x16_bf16(__builtin_bit_cast(bf16x8, mk4(a0.x, a0.y, a1.x, a1.y)), vf, O[tt], 0, 0, 0);
          }
        }
    }
    {
      bf16_t* obase = ob + (row0 + (dir ? 63 - 4 * h : 4 * h)) * 512 + hh * 128 + 32 * w + l31;
      asm volatile("" : "+v"(obase));
#pragma unroll
      for (int tt = 0; tt < 2; ++tt)
#pragma unroll
        for (int i = 0; i < 16; ++i) {
          const int tq = tt * 32 + (i & 3) + 8 * (i >> 2);
          if (dir) *(obase - tq * 512) = f2bf(O[tt][i]); else *(obase + tq * 512) = f2bf(O[tt][i]);
        }
    }
    __builtin_amdgcn_sched_barrier(0);
    if (k + 1 < 36) {
      gload_r(k + 1);
    }
    __builtin_amdgcn_sched_barrier(0);
    const float g63 = sGc[63], eg63 = __expf(g63);
#pragma unroll
    for (int st = 0; st < 2; ++st)
#pragma unroll
      for (int i = 0; i < 16; ++i) X[st][i] *= __expf(g63 - sGc[st * 32 + (i & 3) + 8 * (i >> 2) + 4 * h]);
#pragma unroll
    for (int dq = 0; dq < 4; ++dq) S[dq] = S[dq] * eg63;
    {
      const char* sKt = bufc;
#pragma unroll
      for (int st = 0; st < 2; ++st)
#pragma unroll
        for (int s2 = 0; s2 < 2; ++s2) {
          const bf16x8 vf = __builtin_bit_cast(bf16x8, mk4(pk2(X[st][8 * s2], X[st][8 * s2 + 1]), pk2(X[st][8 * s2 + 2], X[st][8 * s2 + 3]),
                                                           pk2(X[st][8 * s2 + 4], X[st][8 * s2 + 5]), pk2(X[st][8 * s2 + 6], X[st][8 * s2 + 7])));
#pragma unroll
          for (int dq = 0; dq < 4; ++dq) {
            const char* a = sKt + (dq * 32 + l31) * 144 + (st * 32 + 16 * s2 + 4 * h) * 2;
            const u32x2 a0 = *(const u32x2*)a, a1 = *(const u32x2*)(a + 16);
            S[dq] = __builtin_amdgcn_mfma_f32_32x32x16_bf16(__builtin_bit_cast(bf16x8, mk4(a0.x, a0.y, a1.x, a1.y)), vf, S[dq], 0, 0, 0);
          }
        }
    }
    if (k + 1 < 36 && tid < 64) sG[((k + 1) & 1) * 64 + tid] = rg;
  }
  __syncthreads();
}

DI void post_phase(const Params& p, int l, bool skip_ctx) {
  const bf16_t* P = (const bf16_t*)(p.ws + OFF_BIG);
  const bf16_t* oa = (const bf16_t*)(p.ws + OFF_HSA);
  const bf16_t* oc = (const bf16_t*)(p.ws + OFF_HSC);
  bf16_t* Y = (bf16_t*)(p.ws + OFF_Y);
  const int total = M * 128;
#pragma unroll 2
  for (int idx = bid_() * 256 + tid_(); idx < total; idx += gridDim.x * 256) {
    const int row = idx >> 7, r = idx & 127, br = r >> 6, hh = (r >> 4) & 3, ck = r & 15;
    if (skip_ctx && (row % TT) < CTX) continue;
    const int col = hh * 128 + ck * 8;
    const bf16_t* ob = (br ? oc : oa) + (size_t)row * 512 + col;
    float a0[8], a1[8], gt[8], v[8];
    unpack8(*(const u32x4*)ob, a0);
    unpack8(*(const u32x4*)(ob + (size_t)M * 512), a1);
    unpack8(*(const u32x4*)(P + (size_t)row * PLD + (br ? P_CZ : P_AO) + col), gt);
    float ss = 0.f;
#pragma unroll
    for (int e = 0; e < 8; ++e) { v[e] = a0[e] + a1[e]; ss += v[e] * v[e]; }
    ss += dpp_xor1(ss);
    ss += dpp_xor2(ss);
    ss += __shfl_xor(ss, 4);
    ss += __shfl_xor(ss, 8);
    const float rstd = rsqrtf(ss * (1.f / 128.f) + 1e-6f);
    const float* nw = br ? p.c_norm_w + l * 128 + ck * 8 : p.a_norm_w + l * 512 + col;
    const float4 w0 = *(const float4*)nw, w1 = *(const float4*)(nw + 4);
    const float wv[8] = {w0.x, w0.y, w0.z, w0.w, w1.x, w1.y, w1.z, w1.w};
    float y[8];
#pragma unroll
    for (int e = 0; e < 8; ++e) y[e] = v[e] * rstd * wv[e] * (br ? siluf_(gt[e]) : sigmoidf_(gt[e]));
    *(u32x4*)(Y + (size_t)row * 1536 + (br ? 1024 : 0) + col) = mk4(pk2(y[0], y[1]), pk2(y[2], y[3]), pk2(y[4], y[5]), pk2(y[6], y[7]));
  }
}

DI void ffn_act_phase(const Params& p, int l, bool skip_ctx) {
  const bf16_t* U = (const bf16_t*)(p.ws + OFF_BIG);
  bf16_t* act = (bf16_t*)(p.ws + OFF_ACT);
  const float* fw = p.ffn_conv_w + (size_t)l * 3 * 5632;
  const int total = (M / 16) * 352;
  for (int idx = bid_() * 256 + tid_(); idx < total; idx += gridDim.x * 256) {
    const int grp = idx / 352, c0 = (idx - grp * 352) * 8;
    const int row0 = grp * 16, t0 = row0 % TT;
    if (skip_ctx && t0 < CTX) continue;
    float wa[3][8], wg[3][8];
#pragma unroll
    for (int jj = 0; jj < 3; ++jj)
#pragma unroll
      for (int q = 0; q < 2; ++q) {
        const float4 va = *(const float4*)(fw + jj * 5632 + c0 + 4 * q), vg = *(const float4*)(fw + jj * 5632 + DFF + c0 + 4 * q);
        wa[jj][4 * q] = va.x; wa[jj][4 * q + 1] = va.y; wa[jj][4 * q + 2] = va.z; wa[jj][4 * q + 3] = va.w;
        wg[jj][4 * q] = vg.x; wg[jj][4 * q + 1] = vg.y; wg[jj][4 * q + 2] = vg.z; wg[jj][4 * q + 3] = vg.w;
      }
    const bf16_t* ur = U + (size_t)row0 * 5632 + c0;
    const u32x4 z = mk4(0u, 0u, 0u, 0u);
    const bool hp = (t0 != 0 && t0 != CTX);
    const bool hn = (t0 + 15 != CTX - 1 && t0 + 15 != TT - 1);
    u32x4 pa = hp ? *(const u32x4*)(ur - 5632) : z, pg = hp ? *(const u32x4*)(ur - 5632 + DFF) : z;
    u32x4 ca = *(const u32x4*)ur, cg = *(const u32x4*)(ur + DFF);
#pragma unroll 4
    for (int rr = 0; rr < 16; ++rr) {
      const bool has = rr < 15 || hn;
      const bf16_t* un = ur + (size_t)(rr + 1) * 5632;
      const u32x4 na = has ? *(const u32x4*)un : z, ng = has ? *(const u32x4*)(un + DFF) : z;
      float fp[8], fc[8], fn[8], gp[8], gc[8], gn[8];
      unpack8(pa, fp); unpack8(ca, fc); unpack8(na, fn);
      unpack8(pg, gp); unpack8(cg, gc); unpack8(ng, gn);
      unsigned o[4];
#pragma unroll
      for (int e = 0; e < 4; ++e) {
        const float a0 = wa[0][2 * e] * fp[2 * e] + wa[1][2 * e] * fc[2 * e] + wa[2][2 * e] * fn[2 * e];
        const float a1 = wa[0][2 * e + 1] * fp[2 * e + 1] + wa[1][2 * e + 1] * fc[2 * e + 1] + wa[2][2 * e + 1] * fn[2 * e + 1];
        const float g0 = wg[0][2 * e] * gp[2 * e] + wg[1][2 * e] * gc[2 * e] + wg[2][2 * e] * gn[2 * e];
        const float g1 = wg[0][2 * e + 1] * gp[2 * e + 1] + wg[1][2 * e + 1] * gc[2 * e + 1] + wg[2][2 * e + 1] * gn[2 * e + 1];
        o[e] = pk2(a0 * siluf_(g0), a1 * siluf_(g1));
      }
      *(u32x4*)(act + (size_t)(row0 + rr) * DFF + c0) = mk4(o[0], o[1], o[2], o[3]);
      pa = ca; pg = cg; ca = na; cg = ng;
    }
  }
}

__global__ void __launch_bounds__(256, 2) hybrid_fwd(Params p) {
  __shared__ __attribute__((aligned(16))) char smem[73728];
  cg::grid_group grid = cg::this_grid();
  __shared__ u32x4 xb_words;
  if (threadIdx.x == 0) xb_words = mk4(0u, 0u, 0u, 0u);
  __syncthreads();
  (void)xcd_barrier_post((unsigned*)(p.ws + OFF_BAR), (volatile LAS unsigned*)&xb_words);
#define GBAR() do { XcdBarrier xb_; xb_.bar = (unsigned*)(p.ws + OFF_BAR); xb_.x = xb_xcc_id(); xb_.st = (volatile LAS unsigned*)&xb_words; xcd_barrier(xb_); } while (0)
  const int G = gridDim.x;
  bf16_t* wbf = (bf16_t*)(p.ws + OFF_WBF);
  bf16_t* XN = (bf16_t*)(p.ws + OFF_XN);
  bf16_t* BIG = (bf16_t*)(p.ws + OFF_BIG);
  bf16_t* Y = (bf16_t*)(p.ws + OFF_Y);
  bf16_t* ACT = (bf16_t*)(p.ws + OFF_ACT);
  float* MOD = (float*)(p.ws + OFF_MOD);
  float* GATES = (float*)(p.ws + OFF_GATES);

  for (int it = bid_(); it < 384; it += G) ada_partial(p, it, smem);
  __syncthreads();
  convert_weights(p, 0, smem);
  {
    const int tid = tid_(), bid = bid_();
    if (bid == 0) {
      float* rope = (float*)(p.ws + OFF_ROPE);
      for (int i = tid; i < 1024; i += 256) {
        int pos = i >> 4, f = i & 15;
        float inv = exp2f(-(float)f * (13.287712379549449f / 16.f));
        float ang = (float)pos * inv;
        rope[i] = cosf(ang);
        rope[1024 + i] = sinf(ang);
      }
    }
  }
  if (p.ws == nullptr) grid.sync();
  GBAR();
  {
    const float* part = (const float*)(p.ws + OFF_ACT);
    const int tid = tid_(), bid = bid_();
    for (int i = bid * 256 + tid; i < DEPTH * 9 * 6144; i += G * 256) {
      int l = i / (9 * 6144), rem = i - l * 9 * 6144;
      float s = p.ada_b[l * 6144 + rem % 6144];
#pragma unroll
      for (int kc = 0; kc < 16; ++kc) s += part[(size_t)(l * 16 + kc) * 9 * 6144 + rem];
      MOD[i] = s;
    }
  }
  GBAR();

  for (int l = 0; l < DEPTH; ++l) {
    const bool last = (l == DEPTH - 1);
    const float* modl = MOD + (size_t)l * 9 * 6144;
    if (l > 0) convert_weights(p, l, smem);
    norm_phase(p, l, 0, false);
    GBAR();
    for (int base = 0; base < 72 * 35; base += G) {
      int pm, pn;
      if (!tile_of8(base, 72, 35, pm, pn)) continue;
      f32x16 acc[4][2];
      {
        const f32x16 z = {0.f, 0.f, 0.f, 0.f, 0.f, 0.f, 0.f, 0.f, 0.f, 0.f, 0.f, 0.f, 0.f, 0.f, 0.f, 0.f};
#pragma unroll
        for (int mi = 0; mi < 4; ++mi) { acc[mi][0] = z; acc[mi][1] = z; }
      }
      gemm_big(acc, XN + (size_t)pm * 256 * 1024, 1024, wbf + W_IN + (size_t)pn * 128 * 1024, wbf + W_IN + (size_t)(pn * 128 + 64) * 1024, 1024, 1024, smem);
      if (pn < 34) {
        store_bf16_big(acc, BIG + (size_t)pm * 256 * PLD + pn * 128, PLD);
      } else {
        const int tid = tid_(), lane = tid & 63, wave = tid >> 6;
        const int wr = wave >> 1, wc = wave & 1;
        const int c = lane & 31;
        if (wc == 0) {
          float bias = 0.f, alog = 0.f;
          if (c < 16) bias = p.a_gate_b[l * 16 + c];
          else if (c < 24) { bias = p.c_dt_bias[l * 8 + c - 16]; alog = -__expf(p.c_a_log[l * 8 + c - 16]); }
#pragma unroll
          for (int mi = 0; mi < 4; ++mi)
#pragma unroll
            for (int i = 0; i < 16; ++i) {
              int r = pm * 256 + wr * 128 + mi * 32 + (i & 3) + 8 * (i >> 2) + 4 * (lane >> 5);
              float v = acc[mi][0][i] + bias, o;
              if (c < 16) o = ((c >> 2) & 1) ? logsigmoidf_(v) : v;
              else if (c < 24) o = alog * softplusf_(v);
              else o = sigmoidf_(v);
              GATES[(size_t)r * 32 + c] = o;
            }
        }
      }
    }
    GBAR();
    prep_phase(p, l, smem);
    GBAR();
    for (int it = bid_(); it < NB * 36 * 8; it += G) gdn_pre_item(p, it, smem);
    GBAR();
    {
      const int bid = bid_();
      const int nsb = G > 128 ? 128 : 0;
      for (int s = bid; s < 128; s += G) {
        if (s < 64) gdn_chunk_item(p, s, smem); else mlstm_chunk_item(p, s - 64, smem);
      }
      const int nab = G - nsb, ab = bid - nsb;
      const int nitems = last ? 1024 : 1152;
      if (ab >= 0) for (int it = ab; it < nitems; it += nab) attn_item(p, it, smem);
    }
    GBAR();
    post_phase(p, l, last);
    GBAR();
    {
      const int tl = ((G & 7) == 0) ? (bid_() & 7) * (G >> 3) + (bid_() >> 3) : bid_();
      const int nfull = (G == 512) ? 1024 : 1152;
      for (int t = tl; t < 1152 + (1152 - nfull); t += G) {
        const bool half = t >= nfull;
        const int tb = half ? nfull + ((t - nfull) >> 1) : t;
        const int hsel = half ? ((t - nfull) & 1) : 0;
        const int g = tb / 128, r = tb - g * 128;
        const int pm = g * 16 + (r & 15), pn = r >> 4;
        if (last && (pm % 18) < 2) continue;
        const bf16_t* xa = XN + (size_t)pm * 128 * 1024;
        if (!half) {
          unsigned op[2][2][8];
#pragma unroll
          for (int mi = 0; mi < 2; ++mi)
#pragma unroll
            for (int ni = 0; ni < 2; ++ni)
#pragma unroll
              for (int i = 0; i < 8; ++i) op[mi][ni][i] = 0u;
#pragma unroll 1
          for (int br = 0; br < 3; ++br) {
            unsigned yp[2][2][8];
            {
              f32x16 a2[2][2];
              zero_acc<2>(a2);
              gemm_main<2>(a2, Y + (size_t)pm * 128 * 1536 + br * 512, 1536, wbf + W_B + (size_t)(br * 1024 + pn * 128) * 512, 512, 512, smem);
#pragma unroll
              for (int mi = 0; mi < 2; ++mi)
#pragma unroll
                for (int ni = 0; ni < 2; ++ni)
#pragma unroll
                  for (int i = 0; i < 8; ++i) yp[mi][ni][i] = pk2(a2[mi][ni][2 * i], a2[mi][ni][2 * i + 1]);
            }
            __builtin_amdgcn_sched_barrier(0);
            f32x16 a1[2][2];
            zero_acc<2>(a1);
            gemm_main<2>(a1, xa, 1024, wbf + W_G + (size_t)(br * 1024 + pn * 128) * 1024, 1024, 1024, smem);
#pragma unroll
            for (int mi = 0; mi < 2; ++mi)
#pragma unroll
              for (int ni = 0; ni < 2; ++ni)
#pragma unroll
                for (int i = 0; i < 8; ++i)
                  op[mi][ni][i] = pk2(bflo(op[mi][ni][i]) + sigmoidf_(a1[mi][ni][2 * i]) * bflo(yp[mi][ni][i]),
                                      bfhi(op[mi][ni][i]) + sigmoidf_(a1[mi][ni][2 * i + 1]) * bfhi(yp[mi][ni][i]));
            __builtin_amdgcn_sched_barrier(0);
          }
          {
            const int lane = tid_() & 63, wave = tid_() >> 6, wr = wave >> 1, wc = wave & 1, odd = lane & 1;
            bf16_t* C = BIG + (size_t)pm * 128 * 1024 + pn * 128;
#pragma unroll
            for (int mi = 0; mi < 2; ++mi)
#pragma unroll
              for (int ni = 0; ni < 2; ++ni)
#pragma unroll
                for (int i = 0; i < 8; ++i) {
                  const float v0 = bflo(op[mi][ni][i]), v1 = bfhi(op[mi][ni][i]);
                  const float send = odd ? v0 : v1;
                  const float recv = dpp_xor1(send);
                  const int rr = wr * 64 + mi * 32 + ((2 * i) & 3) + 8 * ((2 * i) >> 2) + 4 * (lane >> 5) + odd;
                  const int cc = wc * 64 + ni * 32 + (lane & 31) - odd;
                  *(unsigned*)(smem + rr * 272 + cc * 2) = odd ? pk2(recv, v1) : pk2(v0, recv);
                }
            __syncthreads();
            const int tid = tid_();
#pragma unroll 4
            for (int it = 0; it < 8; ++it) {
              const int r = (tid >> 4) + 16 * it, ck = tid & 15;
              *(u32x4*)(C + (size_t)r * 1024 + ck * 8) = *(const u32x4*)(smem + r * 272 + ck * 16);
            }
            __syncthreads();
          }
        } else {
          const int cn = pn * 128 + hsel * 64;
          f32x16 outv[2][1];
          zero_acc<1>(outv);
#pragma unroll 1
          for (int br = 0; br < 3; ++br) {
            f32x16 a1[2][1], a2[2][1];
            zero_acc<1>(a1);
            gemm_main<1>(a1, xa, 1024, wbf + W_G + (size_t)(br * 1024 + cn) * 1024, 1024, 1024, smem);
            zero_acc<1>(a2);
            gemm_main<1>(a2, Y + (size_t)pm * 128 * 1536 + br * 512, 1536, wbf + W_B + (size_t)(br * 1024 + cn) * 512, 512, 512, smem);
#pragma unroll
            for (int mi = 0; mi < 2; ++mi)
#pragma unroll
              for (int i = 0; i < 16; ++i) outv[mi][0][i] += sigmoidf_(a1[mi][0][i]) * a2[mi][0][i];
          }
          store_bf16_tile<1>(outv, BIG + (size_t)pm * 128 * 1024 + cn, 1024);
        }
      }
    }
    GBAR();
    auto resid_gemm = [&](const bf16_t* A, int lda, const bf16_t* Wt, int K, int gate_idx, bool first) {
      const int tl = ((G & 7) == 0) ? (bid_() & 7) * (G >> 3) + (bid_() >> 3) : bid_();
      const int nfull = (G == 512) ? 1024 : 1152;
      for (int t = tl; t < 1152 + (1152 - nfull); t += G) {
        const bool half = t >= nfull;
        const int tb = half ? nfull + ((t - nfull) >> 1) : t;
        const int hsel = half ? ((t - nfull) & 1) : 0;
        const int g = tb / 128, r = tb - g * 128;
        const int pm = g * 16 + (r & 15), pn = r >> 4;
        const int b = pm / 18, tt = pm - b * 18;
        if (last && tt < 2) continue;
        float* hb = tt < 2 ? (float*)(p.ws + OFF_HCTX) + (size_t)(b * CTX + tt * 128) * D : p.out + (size_t)(b * SEQ + (tt - 2) * 128) * D;
        const float* hs = !first ? hb : (tt < 2 ? p.ctx + (size_t)(b * CTX + tt * 128) * D : p.x + (size_t)(b * SEQ + (tt - 2) * 128) * D);
        const int tid = tid_(), lane = tid & 63, wave = tid >> 6;
        const int wr = wave >> 1, wc = wave & 1;
        const float* gm = modl + (tt < 2 ? 8 : b) * 6144 + gate_idx * 1024;
        if (!half) {
          f32x16 acc[2][2];
          zero_acc<2>(acc);
          gemm_main<2>(acc, A + (size_t)pm * 128 * lda, lda, Wt + (size_t)pn * 128 * K, K, K, smem);
#pragma unroll
          for (int ni = 0; ni < 2; ++ni)
#pragma unroll
            for (int mi = 0; mi < 2; ++mi)
#pragma unroll
              for (int i = 0; i < 16; ++i) {
                const int rr = wr * 64 + mi * 32 + (i & 3) + 8 * (i >> 2) + 4 * (lane >> 5);
                *(float*)(smem + rr * 528 + (wc * 64 + ni * 32 + (lane & 31)) * 4) = acc[mi][ni][i];
              }
          __syncthreads();
          {
            const int c4 = tid & 31;
            const float4 g4 = *(const float4*)(gm + pn * 128 + c4 * 4);
#pragma unroll 4
            for (int it = 0; it < 16; ++it) {
              const int rr = (tid >> 5) + 8 * it;
              const float4 a4 = *(const float4*)(smem + rr * 528 + c4 * 16);
              const size_t ho = (size_t)rr * D + pn * 128 + c4 * 4;
              const float4 h4 = *(const float4*)(hs + ho);
              *(float4*)(hb + ho) = make_float4(h4.x + g4.x * a4.x, h4.y + g4.y * a4.y, h4.z + g4.z * a4.z, h4.w + g4.w * a4.w);
            }
          }
          __syncthreads();
        } else {
          f32x16 acc[2][1];
          zero_acc<1>(acc);
          gemm_main<1>(acc, A + (size_t)pm * 128 * lda, lda, Wt + (size_t)(pn * 128 + hsel * 64) * K, K, K, smem);
#pragma unroll
          for (int mi = 0; mi < 2; ++mi)
#pragma unroll
            for (int i = 0; i < 16; ++i) {
              const int rr = wr * 64 + mi * 32 + (i & 3) + 8 * (i >> 2) + 4 * (lane >> 5);
              *(float*)(smem + rr * 528 + (wc * 32 + (lane & 31)) * 4) = acc[mi][0][i];
            }
          __syncthreads();
          {
            const int c4 = tid & 15, cb = pn * 128 + hsel * 64;
            const float4 g4 = *(const float4*)(gm + cb + c4 * 4);
#pragma unroll 4
            for (int it = 0; it < 8; ++it) {
              const int rr = (tid >> 4) + 16 * it;
              const float4 a4 = *(const float4*)(smem + rr * 528 + c4 * 16);
              const size_t ho = (size_t)rr * D + cb + c4 * 4;
              const float4 h4 = *(const float4*)(hs + ho);
              *(float4*)(hb + ho) = make_float4(h4.x + g4.x * a4.x, h4.y + g4.y * a4.y, h4.z + g4.z * a4.z, h4.w + g4.w * a4.w);
            }
          }
          __syncthreads();
        }
      }
    };
    resid_gemm(BIG, 1024, wbf + W_O, 1024, 2, l == 0);
    GBAR();
    norm_phase(p, l, 1, last);
    GBAR();
    for (int base = 0; base < 72 * 44; base += G) {
      int pm, pn;
      if (!tile_of8(base, 72, 44, pm, pn)) continue;
      if (last && (pm % 9) == 0) continue;
      f32x16 acc[4][2];
      {
        const f32x16 z = {0.f, 0.f, 0.f, 0.f, 0.f, 0.f, 0.f, 0.f, 0.f, 0.f, 0.f, 0.f, 0.f, 0.f, 0.f, 0.f};
#pragma unroll
        for (int mi = 0; mi < 4; ++mi) { acc[mi][0] = z; acc[mi][1] = z; }
      }
      const int c0 = pn * 64;
      gemm_big(acc, XN + (size_t)pm * 256 * 1024, 1024, wbf + W_UP + (size_t)c0 * 1024, wbf + W_UP + (size_t)(DFF + c0) * 1024, 1024, 1024, smem);
      const int tid = tid_(), lane = tid & 63, wave = tid >> 6, wr = wave >> 1, wc = wave & 1, odd = lane & 1;
#pragma unroll
      for (int mi = 0; mi < 4; ++mi)
#pragma unroll
        for (int ni = 0; ni < 2; ++ni)
#pragma unroll
          for (int i = 0; i < 16; i += 2) {
            const float v0 = acc[mi][ni][i], v1 = acc[mi][ni][i + 1];
            const float recv = dpp_xor1(odd ? v0 : v1);
            const int r = wr * 128 + mi * 32 + (i & 3) + 8 * (i >> 2) + 4 * (lane >> 5) + odd;
            const int c = wc * 64 + ni * 32 + (lane & 31) - odd;
            *(unsigned*)(smem + r * 272 + c * 2) = odd ? pk2(recv, v1) : pk2(v0, recv);
          }
      __syncthreads();
      {
        const int ch8 = tid & 7;
        const float* fw = p.ffn_conv_w + (size_t)l * 3 * 5632 + c0 + ch8 * 8;
        float wa[3][8], wg[3][8];
#pragma unroll
        for (int jj = 0; jj < 3; ++jj)
#pragma unroll
          for (int q = 0; q < 2; ++q) {
            const float4 va = *(const float4*)(fw + jj * 5632 + 4 * q), vg = *(const float4*)(fw + jj * 5632 + DFF + 4 * q);
            wa[jj][4 * q] = va.x; wa[jj][4 * q + 1] = va.y; wa[jj][4 * q + 2] = va.z; wa[jj][4 * q + 3] = va.w;
            wg[jj][4 * q] = vg.x; wg[jj][4 * q + 1] = vg.y; wg[jj][4 * q + 2] = vg.z; wg[jj][4 * q + 3] = vg.w;
          }
        bf16_t* arow = ACT + (size_t)pm * 256 * DFF + c0 + ch8 * 8;
#pragma unroll 2
        for (int it = 0; it < 8; ++it) {
          const int r = 1 + (tid >> 3) + 32 * it;
          if (r < 255) {
            const char* ta = smem + r * 272 + ch8 * 16;
            float fp[8], fc[8], fn[8], gp[8], gc[8], gn[8];
            unpack8(*(const u32x4*)(ta - 272), fp); unpack8(*(const u32x4*)ta, fc); unpack8(*(const u32x4*)(ta + 272), fn);
            unpack8(*(const u32x4*)(ta - 272 + 128), gp); unpack8(*(const u32x4*)(ta + 128), gc); unpack8(*(const u32x4*)(ta + 272 + 128), gn);
            unsigned o[4];
#pragma unroll
            for (int e = 0; e < 4; ++e) {
              const float a0 = wa[0][2 * e] * fp[2 * e] + wa[1][2 * e] * fc[2 * e] + wa[2][2 * e] * fn[2 * e];
              const float a1 = wa[0][2 * e + 1] * fp[2 * e + 1] + wa[1][2 * e + 1] * fc[2 * e + 1] + wa[2][2 * e + 1] * fn[2 * e + 1];
              const float g0 = wg[0][2 * e] * gp[2 * e] + wg[1][2 * e] * gc[2 * e] + wg[2][2 * e] * gn[2 * e];
              const float g1 = wg[0][2 * e + 1] * gp[2 * e + 1] + wg[1][2 * e + 1] * gc[2 * e + 1] + wg[2][2 * e + 1] * gn[2 * e + 1];
              o[e] = pk2(a0 * siluf_(g0), a1 * siluf_(g1));
            }
            *(u32x4*)(arow + (size_t)r * DFF) = mk4(o[0], o[1], o[2], o[3]);
          }
        }
      }
      if (tid < 64) {
        const int er = tid >> 4, ck = tid & 15;
        const int rr = er < 2 ? er : 252 + er;
        *(u32x4*)((bf16_t*)(p.ws + OFF_EDGE) + ((size_t)(pm * 44 + pn) * 4 + er) * 128 + ck * 8) = *(const u32x4*)(smem + rr * 272 + ck * 16);
      }
    }
    GBAR();
    {
      const bf16_t* edge = (const bf16_t*)(p.ws + OFF_EDGE);
      const float* fwb = p.ffn_conv_w + (size_t)l * 3 * 5632;
      for (int idx = bid_() * 256 + tid_(); idx < 72 * 44 * 16; idx += G * 256) {
        const int ch8 = idx & 7, e = (idx >> 3) & 1, tp = idx >> 4;
        const int pm = tp / 44, pn = tp - pm * 44, t9 = pm % 9;
        if (last && t9 == 0) continue;
        const bf16_t* eb = edge + ((size_t)(pm * 44 + pn) * 4) * 128 + ch8 * 8;
        const u32x4 z = mk4(0u, 0u, 0u, 0u);
        u32x4 pa, pg, ca, cg, na, ng;
        if (e == 0) {
          const bool hp = !(t9 == 0 || t9 == 1);
          const bf16_t* pb = eb - (size_t)44 * 4 * 128 + 3 * 128;
          pa = hp ? *(const u32x4*)pb : z; pg = hp ? *(const u32x4*)(pb + 64) : z;
          ca = *(const u32x4*)eb; cg = *(const u32x4*)(eb + 64);
          na = *(const u32x4*)(eb + 128); ng = *(const u32x4*)(eb + 128 + 64);
        } else {
          const bool hn = !(t9 == 0 || t9 == 8);
          const bf16_t* nb = eb + (size_t)44 * 4 * 128;
          pa = *(const u32x4*)(eb + 2 * 128); pg = *(const u32x4*)(eb + 2 * 128 + 64);
          ca = *(const u32x4*)(eb + 3 * 128); cg = *(const u32x4*)(eb + 3 * 128 + 64);
          na = hn ? *(const u32x4*)nb : z; ng = hn ? *(const u32x4*)(nb + 64) : z;
        }
        float fp[8], fc[8], fn[8], gp[8], gc[8], gn[8];
        unpack8(pa, fp); unpack8(ca, fc); unpack8(na, fn); unpack8(pg, gp); unpack8(cg, gc); unpack8(ng, gn);
        const float* fw = fwb + pn * 64 + ch8 * 8;
        unsigned o[4];
#pragma unroll
        for (int q = 0; q < 4; ++q) {
          float av[2], gv[2];
#pragma unroll
          for (int x = 0; x < 2; ++x) {
            const int c = 2 * q + x;
            av[x] = fw[c] * fp[c] + fw[5632 + c] * fc[c] + fw[11264 + c] * fn[c];
            gv[x] = fw[DFF + c] * gp[c] + fw[5632 + DFF + c] * gc[c] + fw[11264 + DFF + c] * gn[c];
          }
          o[q] = pk2(av[0] * siluf_(gv[0]), av[1] * siluf_(gv[1]));
        }
        *(u32x4*)(ACT + (size_t)(pm * 256 + (e ? 255 : 0)) * DFF + pn * 64 + ch8 * 8) = mk4(o[0], o[1], o[2], o[3]);
      }
    }
    GBAR();
    resid_gemm(ACT, DFF, wbf + W_DN, DFF, 5, false);
    GBAR();
  }
}

extern "C" void kernel_launch(void* const* d_in, const int* in_sizes, int n_in, void* d_out, int out_size, void* d_ws, size_t ws_size,
                              hipStream_t stream) {
  if (ws_size < OFF_END) return;
  static int grid_blocks = 0;
  if (!grid_blocks) {
    int dev = 0, cus = 0, per_cu = 0;
    hipGetDevice(&dev);
    hipDeviceGetAttribute(&cus, hipDeviceAttributeMultiprocessorCount, dev);
    hipOccupancyMaxActiveBlocksPerMultiprocessor(&per_cu, hybrid_fwd, 256, 0);
    if (per_cu > 2) per_cu = 2;
    if (per_cu < 1) per_cu = 1;
    grid_blocks = cus * per_cu;
  }
  Params p{};
  const float** pp = (const float**)&p;
  for (int i = 0; i < 22; ++i) pp[i] = (const float*)d_in[i];
  p.out = (float*)d_out;
  p.ws = (char*)d_ws;
  hipMemsetAsync((char*)d_ws + OFF_BAR, 0, 16384, stream);
  void* args[] = {&p};
  hipLaunchCooperativeKernel((void*)hybrid_fwd, dim3(grid_blocks), dim3(256), args, 0, stream);
}
```

```cpp
#include <hip/hip_runtime.h>
#include <hip/hip_cooperative_groups.h>
namespace cg = cooperative_groups;

typedef unsigned short bf16_t;
typedef short bf16x8 __attribute__((ext_vector_type(8)));
typedef float f32x16 __attribute__((ext_vector_type(16)));
typedef __bf16 bf2v __attribute__((ext_vector_type(2)));
typedef float f2v __attribute__((ext_vector_type(2)));
typedef unsigned u32x4 __attribute__((ext_vector_type(4)));
typedef unsigned u32x2 __attribute__((ext_vector_type(2)));
#define DI __device__ __forceinline__

constexpr int D = 1024, NB = 8, SEQ = 2048, CTX = 256, TT = 2304  , M = NB * TT  ;
constexpr int DEPTH = 4, INC = 7456, DFF = 2816, PLD = 4352;
constexpr int P_AQ = 0, P_AK = 256, P_AV = 512, P_AO = 1024, P_BQ = 1536, P_BK = 2048, P_BV = 2176, P_CQ = 2304, P_CZ = 3840;
constexpr int NIN = 4480;
constexpr size_t W_IN = 0, W_G = W_IN + (size_t)NIN * 1024, W_B = W_G + (size_t)3072 * 1024, W_O = W_B + (size_t)3 * 1024 * 512,
                 W_UP = W_O + (size_t)1024 * 1024, W_DN = W_UP + (size_t)5632 * 1024, W_END = W_DN + (size_t)1024 * 2816;
constexpr size_t OFF_WBF = 0;
constexpr size_t OFF_HCTX = OFF_WBF + W_END * 2;
constexpr size_t OFF_XN = OFF_HCTX + (size_t)NB * CTX * D * 4;
constexpr size_t OFF_BIG = OFF_XN + (size_t)M * D * 2;
constexpr size_t OFF_HSA = OFF_BIG + (size_t)M * PLD * 2;
constexpr size_t OFF_Y = OFF_BIG + (size_t)M * 5632 * 2;
constexpr size_t OFF_ACT = OFF_Y + (size_t)M * 1536 * 2;
constexpr size_t OFF_HSC = OFF_ACT + (size_t)M * 1536 * 2;
constexpr size_t OFF_GATES = OFF_ACT + (size_t)M * DFF * 2;
constexpr size_t OFF_VT = OFF_GATES + (size_t)M * 32 * 4;
constexpr size_t OFF_MOD = OFF_VT + (size_t)NB * 2 * 64 * TT * 2;
constexpr size_t OFF_ROPE = OFF_MOD + (size_t)DEPTH * 9 * 6144 * 4;
constexpr size_t OFF_BAR = OFF_ROPE + 2048 * 4;
constexpr size_t OFF_AUX = OFF_BAR + 16384;
constexpr size_t OFF_JUNK = OFF_AUX + (size_t)M * 32 * 4;
constexpr size_t OFF_EDGE = OFF_JUNK + 1048576;
constexpr size_t OFF_END = OFF_EDGE + (size_t)72 * 44 * 4 * 128 * 2;
static_assert(OFF_HSA + (size_t)M * 512 * 4 <= OFF_Y, "hsum A fits");
static_assert(OFF_HSC + (size_t)M * 512 * 4 <= OFF_GATES, "hsum C fits");

struct Params {
  const float *x, *c, *ctx, *c_ctx, *norm1_w, *norm2_w, *ada_w, *ada_b, *w_in, *a_gate_b, *a_norm_w, *b_qnorm_w, *b_knorm_w,
      *c_conv_w, *c_a_log, *c_dt_bias, *c_norm_w, *w_branch, *w_out, *w_up, *ffn_conv_w, *w_down;
  float* out;
  char* ws;
};

DI int tid_() { int t = threadIdx.x; asm volatile("" : "+v"(t)); return t; }
DI int bid_() { int b = blockIdx.x; asm volatile("" : "+s"(b)); return b; }
DI unsigned pk2(float a, float b) { f2v v = {a, b}; return __builtin_bit_cast(unsigned, __builtin_convertvector(v, bf2v)); }
DI u32x4 mk4(unsigned a, unsigned b, unsigned c, unsigned d) { u32x4 r = {a, b, c, d}; return r; }
DI u32x2 mk2(unsigned a, unsigned b) { u32x2 r = {a, b}; return r; }
DI float bflo(unsigned u) { return __uint_as_float(u << 16); }
DI float bfhi(unsigned u) { return __uint_as_float(u & 0xffff0000u); }
DI float bf2f(bf16_t u) { return __uint_as_float(((unsigned)u) << 16); }
DI bf16_t f2bf(float a) { return (bf16_t)(pk2(a, 0.f) & 0xffffu); }
DI float wsum(float v) {
#pragma unroll
  for (int o = 32; o; o >>= 1) v += __shfl_xor(v, o);
  return v;
}
DI float dpp_xor1(float v) { return __builtin_bit_cast(float, __builtin_amdgcn_update_dpp(0, __builtin_bit_cast(int, v), 0xB1, 0xF, 0xF, true)); }
DI float dpp_xor2(float v) { return __builtin_bit_cast(float, __builtin_amdgcn_update_dpp(0, __builtin_bit_cast(int, v), 0x4E, 0xF, 0xF, true)); }
DI float sigmoidf_(float x) { return 1.f / (1.f + __expf(-x)); }
DI float siluf_(float x) { return x / (1.f + __expf(-x)); }
DI float logsigmoidf_(float x) { return fminf(x, 0.f) - __logf(1.f + __expf(-fabsf(x))); }
DI float softplusf_(float x) { return fmaxf(x, 0.f) + __logf(1.f + __expf(-fabsf(x))); }
DI void unpack8(u32x4 u, float* f) {
  f[0] = bflo(u.x); f[1] = bfhi(u.x); f[2] = bflo(u.y); f[3] = bfhi(u.y);
  f[4] = bflo(u.z); f[5] = bfhi(u.z); f[6] = bflo(u.w); f[7] = bfhi(u.w);
}
DI float* hrow(const Params& p, int row) {
  int b = row / TT, t = row - b * TT;
  return t < CTX ? (float*)(p.ws + OFF_HCTX) + (size_t)(b * CTX + t) * D : p.out + (size_t)(b * SEQ + t - CTX) * D;
}


#define XB_TMO      128
#define XB_XCNT(j)  (256  + 64 * (j))
#define XB_XSUB(j)  (1280 + 64 * (j))
#define XB_XGEN(j)  (2304 + 64 * (j))
#define XB_TOP      3328
#define XB_TOPGEN   3392
#define XCD_BAR_WORDS 3456
#define XB_SPIN_CAP (1u << 22)
#define LAS __attribute__((address_space(3)))
DI unsigned xb_ld(unsigned* p) { return __hip_atomic_load(p, __ATOMIC_RELAXED, __HIP_MEMORY_SCOPE_AGENT); }
DI unsigned xb_add(unsigned* p, unsigned v) { return __hip_atomic_fetch_add(p, v, __ATOMIC_RELAXED, __HIP_MEMORY_SCOPE_AGENT); }
DI unsigned xb_xcc_id() { return (unsigned)__builtin_amdgcn_s_getreg((3 << 11) | 20) & 0xFu; }
#define XB_SPIN(cond, bar) do { unsigned _sp = 0; while (cond) { __builtin_amdgcn_s_sleep(1); \
    if ((++_sp & 255u) == 0u) { if (xb_ld(&(bar)[XB_TMO])) break; if (_sp > XB_SPIN_CAP) { atomicAdd(&(bar)[XB_TMO], 1u); break; } } } } while (0)
struct XcdBarrier { unsigned* bar; unsigned x; volatile LAS unsigned* st; };
DI XcdBarrier xcd_barrier_post(unsigned* bar, volatile LAS unsigned* st) {
  XcdBarrier b; b.bar = bar; b.x = xb_xcc_id(); b.st = st;
  if (threadIdx.x == 0) (void)xb_add(&bar[XB_XCNT(b.x)], 1u);
  return b;
}
DI void xcd_barrier_complete(unsigned* bar, unsigned x, unsigned& nloc, unsigned& nx) {
  const unsigned G = gridDim.x;
  unsigned sum, cnt, mine, sp = 0u;
  for (;;) {
    sum = 0u; cnt = 0u; mine = 0u;
#pragma unroll
    for (unsigned j = 0; j < 16; ++j) { const unsigned c = xb_ld(&bar[XB_XCNT(j)]); sum += c; cnt += (c > 0u) ? 1u : 0u; mine = (j == x) ? c : mine; }
    if (sum == G) break;
    __builtin_amdgcn_s_sleep(1);
    if ((++sp & 255u) == 0u) { if (xb_ld(&bar[XB_TMO])) break; if (sp > XB_SPIN_CAP) { atomicAdd(&bar[XB_TMO], 1u); break; } }
  }
  nloc = mine > 0u ? mine : 1u; nx = cnt > 0u ? cnt : 1u;
}
DI void xcd_barrier(const XcdBarrier& b) {
  asm volatile("s_waitcnt vmcnt(0)" ::: "memory");
  __syncthreads();
  if (threadIdx.x == 0) {
    unsigned* bar = b.bar;
    __builtin_amdgcn_s_waitcnt(0);
    unsigned nloc = b.st[0], nx = b.st[1];
    if (nloc == 0u) { xcd_barrier_complete(bar, b.x, nloc, nx); b.st[0] = nloc; b.st[1] = nx; }
    const unsigned old = xb_add(&bar[XB_XSUB(b.x)], 1u);
    const unsigned gen = old / nloc;
    if (old + 1u == (gen + 1u) * nloc) {
      __builtin_amdgcn_fence(__ATOMIC_RELEASE, "agent");
      asm volatile("s_waitcnt vmcnt(0)" ::: "memory");
      const unsigned og = xb_add(&bar[XB_TOP], 1u);
      const unsigned tg = og / nx;
      if (og + 1u == (tg + 1u) * nx) xb_add(&bar[XB_TOPGEN], 1u);
      else XB_SPIN(xb_ld(&bar[XB_TOPGEN]) == tg, bar);
      __builtin_amdgcn_fence(__ATOMIC_ACQUIRE, "agent");
      xb_add(&bar[XB_XGEN(b.x)], 1u);
      asm volatile("s_waitcnt vmcnt(0)" ::: "memory");
    } else {
      XB_SPIN(xb_ld(&bar[XB_XGEN(b.x)]) == gen, bar);
      __builtin_amdgcn_fence(__ATOMIC_ACQUIRE, "agent");
      asm volatile("s_waitcnt vmcnt(0)" ::: "memory");
    }
  }
  __syncthreads();
}

template <int NI>
DI void gemm_main(f32x16 (&acc)[2][NI], const bf16_t* __restrict__ A, int lda, const bf16_t* __restrict__ Bt, int ldb, int K, char* smem) {
  constexpr int BN = 64 * NI;
  constexpr int ABYTES = 128 * 144, STAGE = ABYTES + BN * 144;
  const int tid = tid_(), lane = tid & 63, wave = tid >> 6, wr = wave >> 1, wc = wave & 1;
  const int lr = tid >> 3, lc = tid & 7;
  const bf16_t* ga = A + (size_t)lr * lda + lc * 8;
  const bf16_t* gb = Bt + (size_t)lr * ldb + lc * 8;
  u32x4 ra[4], rb[2 * NI];
  const int nk = K >> 6;
#pragma unroll
  for (int i = 0; i < 4; ++i) ra[i] = *(const u32x4*)(ga + (size_t)(32 * i) * lda);
#pragma unroll
  for (int i = 0; i < 2 * NI; ++i) rb[i] = *(const u32x4*)(gb + (size_t)(32 * i) * ldb);
  {
    char* base = smem;
#pragma unroll
    for (int i = 0; i < 4; ++i) *(u32x4*)(base + (lr + 32 * i) * 144 + lc * 16) = ra[i];
#pragma unroll
    for (int i = 0; i < 2 * NI; ++i) *(u32x4*)(base + ABYTES + (lr + 32 * i) * 144 + lc * 16) = rb[i];
  }
  const int aoff = (wr * 64 + (lane & 31)) * 144 + (lane >> 5) * 16;
  const int boff = ABYTES + (wc * 32 * NI + (lane & 31)) * 144 + (lane >> 5) * 16;
  for (int kt = 0; kt < nk; ++kt) {
    const bool more = (kt + 1 < nk);
    if (more) {
      const int k0 = (kt + 1) * 64;
#pragma unroll
      for (int i = 0; i < 4; ++i) ra[i] = *(const u32x4*)(ga + (size_t)(32 * i) * lda + k0);
#pragma unroll
      for (int i = 0; i < 2 * NI; ++i) rb[i] = *(const u32x4*)(gb + (size_t)(32 * i) * ldb + k0);
    }
    __syncthreads();
    const char* sb = smem + (kt & 1) * STAGE;
#pragma unroll
    for (int ks = 0; ks < 4; ++ks) {
      bf16x8 af[2], bfr[NI];
#pragma unroll
      for (int mi = 0; mi < 2; ++mi) af[mi] = *(const bf16x8*)(sb + aoff + mi * 32 * 144 + ks * 32);
#pragma unroll
      for (int ni = 0; ni < NI; ++ni) bfr[ni] = *(const bf16x8*)(sb + boff + ni * 32 * 144 + ks * 32);
#pragma unroll
      for (int mi = 0; mi < 2; ++mi)
#pragma unroll
        for (int ni = 0; ni < NI; ++ni) acc[mi][ni] = __builtin_amdgcn_mfma_f32_32x32x16_bf16(af[mi], bfr[ni], acc[mi][ni], 0, 0, 0);
    }
    if (more) {
      char* base = smem + ((kt + 1) & 1) * STAGE;
#pragma unroll
      for (int i = 0; i < 4; ++i) *(u32x4*)(base + (lr + 32 * i) * 144 + lc * 16) = ra[i];
#pragma unroll
      for (int i = 0; i < 2 * NI; ++i) *(u32x4*)(base + ABYTES + (lr + 32 * i) * 144 + lc * 16) = rb[i];
    }
  }
  __syncthreads();
}

template <int NI>
DI void zero_acc(f32x16 (&acc)[2][NI]) {
  const f32x16 z = {0.f, 0.f, 0.f, 0.f, 0.f, 0.f, 0.f, 0.f, 0.f, 0.f, 0.f, 0.f, 0.f, 0.f, 0.f, 0.f};
#pragma unroll
  for (int mi = 0; mi < 2; ++mi)
#pragma unroll
    for (int ni = 0; ni < NI; ++ni) acc[mi][ni] = z;
}

DI bool tile_of(int base, int ntm, int ntn, int& pm, int& pn) {
  const int G = gridDim.x, bid = bid_();
  int tl = ((G & 7) == 0) ? (bid & 7) * (G >> 3) + (bid >> 3) : bid;
  int t = base + tl;
  if (t >= ntm * ntn) return false;
  const int per = 16 * ntn;
  int g = t / per, r = t - g * per;
  pm = g * 16 + (r & 15);
  pn = r >> 4;
  return true;
}

template <int NI>
DI void store_bf16_tile(const f32x16 (&acc)[2][NI], bf16_t* C, int ldc) {
  const int lane = tid_() & 63, wave = tid_() >> 6, wr = wave >> 1, wc = wave & 1, odd = lane & 1;
#pragma unroll
  for (int mi = 0; mi < 2; ++mi)
#pragma unroll
    for (int ni = 0; ni < NI; ++ni)
#pragma unroll
      for (int i = 0; i < 16; i += 2) {
        float v0 = acc[mi][ni][i], v1 = acc[mi][ni][i + 1];
        float send = odd ? v0 : v1;
        float recv = dpp_xor1(send);
        int r = wr * 64 + mi * 32 + (i & 3) + 8 * (i >> 2) + 4 * (lane >> 5) + odd;
        int c = wc * 32 * NI + ni * 32 + (lane & 31) - odd;
        unsigned val = odd ? pk2(recv, v1) : pk2(v0, recv);
        *(unsigned*)(C + (size_t)r * ldc + c) = val;
      }
}


DI void gemm_big(f32x16 (&acc)[4][2], const bf16_t* __restrict__ A, int lda, const bf16_t* __restrict__ Bt, const bf16_t* __restrict__ Bt2, int ldb, int K, char* smem) {
  constexpr int ABYTES = 256 * 144;
  const int tid = tid_(), lane = tid & 63, wave = tid >> 6, wr = wave >> 1, wc = wave & 1;
  const int lr = tid >> 3, lc = tid & 7;
  const bf16_t* ga = A + (size_t)lr * lda + lc * 8;
  const bf16_t* gb = Bt + (size_t)lr * ldb + lc * 8;
  const bf16_t* gb2 = Bt2 + (size_t)lr * ldb + lc * 8;
  u32x4 ra[8], rb[4];
  const int nk = K >> 6;
#pragma unroll
  for (int i = 0; i < 8; ++i) ra[i] = *(const u32x4*)(ga + (size_t)(32 * i) * lda);
#pragma unroll
  for (int i = 0; i < 4; ++i) rb[i] = *(const u32x4*)((i < 2 ? gb : gb2) + (size_t)(32 * (i & 1)) * ldb);
  const int aoff = (wr * 128 + (lane & 31)) * 144 + (lane >> 5) * 16;
  const int boff = ABYTES + (wc * 64 + (lane & 31)) * 144 + (lane >> 5) * 16;
  for (int kt = 0; kt < nk; ++kt) {
    __syncthreads();
#pragma unroll
    for (int i = 0; i < 8; ++i) *(u32x4*)(smem + (lr + 32 * i) * 144 + lc * 16) = ra[i];
#pragma unroll
    for (int i = 0; i < 4; ++i) *(u32x4*)(smem + ABYTES + (lr + 32 * i) * 144 + lc * 16) = rb[i];
    __syncthreads();
    if (kt + 1 < nk) {
      const int k0 = (kt + 1) * 64;
#pragma unroll
      for (int i = 0; i < 8; ++i) ra[i] = *(const u32x4*)(ga + (size_t)(32 * i) * lda + k0);
#pragma unroll
      for (int i = 0; i < 4; ++i) rb[i] = *(const u32x4*)((i < 2 ? gb : gb2) + (size_t)(32 * (i & 1)) * ldb + k0);
    }
#pragma unroll
    for (int ks = 0; ks < 4; ++ks) {
      bf16x8 af[4], bfr[2];
#pragma unroll
      for (int mi = 0; mi < 4; ++mi) af[mi] = *(const bf16x8*)(smem + aoff + mi * 32 * 144 + ks * 32);
#pragma unroll
      for (int ni = 0; ni < 2; ++ni) bfr[ni] = *(const bf16x8*)(smem + boff + ni * 32 * 144 + ks * 32);
#pragma unroll
      for (int mi = 0; mi < 4; ++mi)
#pragma unroll
        for (int ni = 0; ni < 2; ++ni) acc[mi][ni] = __builtin_amdgcn_mfma_f32_32x32x16_bf16(af[mi], bfr[ni], acc[mi][ni], 0, 0, 0);
    }
  }
  __syncthreads();
}
DI void store_bf16_big(const f32x16 (&acc)[4][2], bf16_t* C, int ldc) {
  const int lane = tid_() & 63, wave = tid_() >> 6, wr = wave >> 1, wc = wave & 1, odd = lane & 1;
#pragma unroll
  for (int mi = 0; mi < 4; ++mi)
#pragma unroll
    for (int ni = 0; ni < 2; ++ni)
#pragma unroll
      for (int i = 0; i < 16; i += 2) {
        float v0 = acc[mi][ni][i], v1 = acc[mi][ni][i + 1];
        float send = odd ? v0 : v1;
        float recv = dpp_xor1(send);
        int r = wr * 128 + mi * 32 + (i & 3) + 8 * (i >> 2) + 4 * (lane >> 5) + odd;
        int c = wc * 64 + ni * 32 + (lane & 31) - odd;
        unsigned val = odd ? pk2(recv, v1) : pk2(v0, recv);
        *(unsigned*)(C + (size_t)r * ldc + c) = val;
      }
}
DI bool tile_of8(int base, int ntm, int ntn, int& pm, int& pn) {
  const int G = gridDim.x, bid = bid_();
  int tl = ((G & 7) == 0) ? (bid & 7) * (G >> 3) + (bid >> 3) : bid;
  int t = base + tl;
  if (t >= ntm * ntn) return false;
  const int per = 8 * ntn;
  int g = t / per, r = t - g * per;
  pm = g * 8 + (r & 7);
  pn = r >> 3;
  return true;
}

DI int win_map(int n) { return n < 1536 ? n : (n < 4352 ? n + 16 : (n < 4368 ? n - 4352 + 1536 : (n < 4384 ? n : -1))); }
DI void convert_tile(const float* __restrict__ src, int ldsrc, int mode, bf16_t* __restrict__ dst, int K, int nt, int kt, char* smem) {
  float* tile = (float*)smem;
  const int tid = tid_();
  const int n0 = nt * 64, k0 = kt * 64, tn = tid & 63, tk = tid >> 6;
  const int n = n0 + tn;
  const int on = mode ? win_map(n) : n;
#pragma unroll 4
  for (int i = 0; i < 16; ++i) {
    int k = tk + 4 * i;
    tile[k * 65 + tn] = on >= 0 ? src[(size_t)(k0 + k) * ldsrc + on] : 0.f;
  }
  __syncthreads();
  const int wn = tid >> 2, kq = tid & 3;
  unsigned o[8];
#pragma unroll
  for (int j = 0; j < 8; ++j) o[j] = pk2(tile[(kq * 16 + 2 * j) * 65 + wn], tile[(kq * 16 + 2 * j + 1) * 65 + wn]);
  u32x4* d = (u32x4*)(dst + (size_t)(n0 + wn) * K + k0 + kq * 16);
  d[0] = mk4(o[0], o[1], o[2], o[3]);
  d[1] = mk4(o[4], o[5], o[6], o[7]);
  __syncthreads();
}
DI void convert_weights(const Params& p, int l, char* smem) {
  bf16_t* wbf = (bf16_t*)(p.ws + OFF_WBF);
  for (int t = bid_(); t < 4640; t += gridDim.x) {
    if (t < 1120) convert_tile(p.w_in + (size_t)l * 1024 * INC, INC, 1, wbf + W_IN, 1024, t >> 4, t & 15, smem);
    else if (t < 1888) { int tt = t - 1120; convert_tile(p.w_in + (size_t)l * 1024 * INC + 4384, INC, 0, wbf + W_G, 1024, tt >> 4, tt & 15, smem); }
    else if (t < 2272) { int tt = t - 1888; int br = tt >> 7, rem = tt & 127;
      convert_tile(p.w_branch + (size_t)(l * 3 + br) * 512 * 1024, 1024, 0, wbf + W_B + (size_t)br * 1024 * 512, 512, rem >> 3, rem & 7, smem); }
    else if (t < 2528) { int tt = t - 2272; convert_tile(p.w_out + (size_t)l * 1024 * 1024, 1024, 0, wbf + W_O, 1024, tt >> 4, tt & 15, smem); }
    else if (t < 3936) { int tt = t - 2528; convert_tile(p.w_up + (size_t)l * 1024 * 5632, 5632, 0, wbf + W_UP, 1024, tt >> 4, tt & 15, smem); }
    else { int tt = t - 3936; convert_tile(p.w_down + (size_t)l * DFF * 1024, 1024, 0, wbf + W_DN, DFF, tt / 44, tt % 44, smem); }
  }
}

DI void ada_partial(const Params& p, int item, char* smem) {
  float* sv = (float*)smem;
  const int tid = tid_();
  const int kc = item & 15, cc = (item >> 4) % 6, l = item / 96;
  const int k0 = kc * 64;
  __syncthreads();
  for (int i = tid; i < 576; i += 256) {
    int r = i >> 6, kk = i & 63;
    float v = r < 8 ? p.c[r * 1024 + k0 + kk] : p.c_ctx[k0 + kk];
    sv[i] = siluf_(v);
  }
  __syncthreads();
  const int col = cc * 1024 + tid * 4;
  float4 acc[9];
#pragma unroll
  for (int r = 0; r < 9; ++r) acc[r] = make_float4(0.f, 0.f, 0.f, 0.f);
  const float* w = p.ada_w + ((size_t)l * 1024 + k0) * 6144 + col;
#pragma unroll 4
  for (int kk = 0; kk < 64; ++kk) {
    float4 wv = *(const float4*)(w + (size_t)kk * 6144);
#pragma unroll
    for (int r = 0; r < 9; ++r) {
      float s = sv[r * 64 + kk];
      acc[r].x += s * wv.x; acc[r].y += s * wv.y; acc[r].z += s * wv.z; acc[r].w += s * wv.w;
    }
  }
  float* part = (float*)(p.ws + OFF_ACT);
#pragma unroll
  for (int r = 0; r < 9; ++r) *(float4*)(part + ((size_t)(l * 16 + kc) * 9 + r) * 6144 + col) = acc[r];
}

DI void norm_phase(const Params& p, int l, int which, bool skip_ctx) {
  const float* nw = (which ? p.norm2_w : p.norm1_w) + l * 1024;
  const float* modl = (const float*)(p.ws + OFF_MOD) + (size_t)l * 9 * 6144;
  bf16_t* xn = (bf16_t*)(p.ws + OFF_XN);
  const int lane = tid_() & 63;
#pragma unroll 2
  for (int row = bid_() * 4 + (tid_() >> 6); row < M; row += gridDim.x * 4) {
    int b = row / TT, t = row - b * TT;
    if (skip_ctx && t < CTX) continue;
    const float* hp = (l == 0 && which == 0) ? (t < CTX ? p.ctx + (size_t)(b * CTX + t) * D : p.x + (size_t)(b * SEQ + t - CTX) * D) : hrow(p, row);
    const float* sh = modl + (t < CTX ? 8 : b) * 6144 + which * 3072;
    const float* sc = sh + 1024;
    float4 v[4];
    float ss = 0.f;
#pragma unroll
    for (int i = 0; i < 4; ++i) {
      v[i] = *(const float4*)(hp + i * 256 + lane * 4);
      ss += v[i].x * v[i].x + v[i].y * v[i].y + v[i].z * v[i].z + v[i].w * v[i].w;
    }
    ss = wsum(ss);
    const float rstd = rsqrtf(ss * (1.f / 1024.f) + 1e-6f);
#pragma unroll
    for (int i = 0; i < 4; ++i) {
      const int col = i * 256 + lane * 4;
      float4 w4 = *(const float4*)(nw + col), s4 = *(const float4*)(sc + col), h4 = *(const float4*)(sh + col);
      float y0 = v[i].x * rstd * w4.x * (1.f + s4.x) + h4.x;
      float y1 = v[i].y * rstd * w4.y * (1.f + s4.y) + h4.y;
      float y2 = v[i].z * rstd * w4.z * (1.f + s4.z) + h4.z;
      float y3 = v[i].w * rstd * w4.w * (1.f + s4.w) + h4.w;
      *(u32x2*)(xn + (size_t)row * 1024 + col) = mk2(pk2(y0, y1), pk2(y2, y3));
    }
  }
}

DI void prep_phase(const Params& p, int l, char* smem) {
  bf16_t* P = (bf16_t*)(p.ws + OFF_BIG);
  bf16_t* cq = (bf16_t*)(p.ws + OFF_ACT);
  const float* rope = (const float*)(p.ws + OFF_ROPE);
  const int tid = tid_(), lane = tid & 63;
  {
    bf16_t* tile = (bf16_t*)smem;
    bf16_t* vt = (bf16_t*)(p.ws + OFF_VT);
    for (int it = bid_(); it < 288; it += gridDim.x) {
      int b = it / 36, t0 = (it - b * 36) * 64;
      __syncthreads();
#pragma unroll
      for (int i = 0; i < 4; ++i) {
        int cid = tid + 256 * i, j = cid >> 4, ec = cid & 15;
        u32x4 v = *(const u32x4*)(P + (size_t)(b * TT + t0 + j) * PLD + P_BV + ec * 8);
        *(u32x4*)(tile + j * 136 + ec * 8) = v;
      }
      __syncthreads();
#pragma unroll
      for (int i = 0; i < 4; ++i) {
        int cid = tid + 256 * i, e = cid >> 3, jc = cid & 7;
        unsigned o[4];
#pragma unroll
        for (int jj = 0; jj < 4; ++jj) o[jj] = (unsigned)tile[(jc * 8 + 2 * jj) * 136 + e] | ((unsigned)tile[(jc * 8 + 2 * jj + 1) * 136 + e] << 16);
        *(u32x4*)(vt + ((size_t)b * 128 + e) * TT + t0 + jc * 8) = mk4(o[0], o[1], o[2], o[3]);
      }
    }
  }
  {
    const float* gates = (const float*)(p.ws + OFF_GATES);
    float* aux = (float*)(p.ws + OFF_AUX);
    for (int it = bid_() * 4 + (tid >> 6); it < NB * 36 * 8; it += gridDim.x * 4) {
      const int hd = it & 7, dir = hd >> 2, hh = hd & 3, cb = it >> 3;
      const int b = cb / 36, c = cb - b * 36;
      const size_t row = (size_t)b * TT + c * 64 + (dir ? 63 - lane : lane);
      const float ig = gates[row * 32 + dir * 8 + hh], lf = gates[row * 32 + dir * 8 + 4 + hh], gg = gates[row * 32 + 16 + dir * 4 + hh];
      float bc = lf, gc = gg;
#pragma unroll
      for (int o = 1; o < 64; o <<= 1) {
        float t1 = __shfl_up(bc, o), t2 = __shfl_up(gc, o);
        if (lane >= o) { bc += t1; gc += t2; }
      }
      const float u = ig - bc;
      float gm = u;
#pragma unroll
      for (int o = 1; o < 64; o <<= 1) {
        float t1 = __shfl_up(gm, o);
        if (lane >= o) gm = fmaxf(gm, t1);
      }
      float* ar = aux + row * 32;
      ar[(dir * 4 + hh) * 3 + 0] = bc; ar[(dir * 4 + hh) * 3 + 1] = u; ar[(dir * 4 + hh) * 3 + 2] = gm;
      ar[24 + dir * 4 + hh] = gc;
    }
  }
  {
    const float* qnw = p.b_qnorm_w + l * 64;
    const float* knw = p.b_knorm_w + l * 64;
    const int total = M * 40;
#pragma unroll 2
    for (int idx = bid_() * 256 + tid; idx < total; idx += gridDim.x * 256) {
      const int row = idx / 40, r40 = idx - row * 40, hd = r40 >> 2, sub = r40 & 3, a = sub >> 1, f0 = (sub & 1) * 8;
      const int t = row % TT;
      const bool isq = hd < 8;
      bf16_t* base = P + (size_t)row * PLD + (isq ? P_BQ + hd * 64 : P_BK + (hd - 8) * 64) + a * 32 + f0;
      const u32x4 u1 = *(const u32x4*)base, u2 = *(const u32x4*)(base + 16);
      float x1[8], x2[8];
      unpack8(u1, x1); unpack8(u2, x2);
      float ss = 0.f;
#pragma unroll
      for (int e = 0; e < 8; ++e) ss += x1[e] * x1[e] + x2[e] * x2[e];
      ss += dpp_xor1(ss);
      ss += dpp_xor2(ss);
      const float rstd = rsqrtf(ss * (1.f / 64.f) + 1e-6f);
      const float* nwp = (isq ? qnw : knw) + a * 32 + f0;
      const float osc = isq ? 0.125f * 1.4426950408889634f : 1.f;
      const bool lat = t >= CTX;
      const int tl = t - CTX;
      const int pos = lat ? (a == 0 ? (tl >> 6) : (tl & 63)) : 0;
      float o1[8], o2[8];
#pragma unroll
      for (int e = 0; e < 8; ++e) {
        const float y1 = x1[e] * rstd * nwp[e], y2 = x2[e] * rstd * nwp[16 + e];
        const float cs = lat ? rope[pos * 16 + f0 + e] : 1.f, sn = lat ? rope[1024 + pos * 16 + f0 + e] : 0.f;
        o1[e] = (y1 * cs - y2 * sn) * osc;
        o2[e] = (y2 * cs + y1 * sn) * osc;
      }
      *(u32x4*)base = mk4(pk2(o1[0], o1[1]), pk2(o1[2], o1[3]), pk2(o1[4], o1[5]), pk2(o1[6], o1[7]));
      *(u32x4*)(base + 16) = mk4(pk2(o2[0], o2[1]), pk2(o2[2], o2[3]), pk2(o2[4], o2[5]), pk2(o2[6], o2[7]));
    }
  }
  {
    const float* cw = p.c_conv_w + (size_t)l * 3 * 1536;
    const int total = (M / 16) * 192;
    for (int idx = bid_() * 256 + tid; idx < total; idx += gridDim.x * 256) {
      const int grp = idx / 192, ck = idx - grp * 192, ch = ck * 8, ph = ck >> 4;
      const int row0 = grp * 16, t0 = row0 % TT;
      float w0[8], w1[8], w2[8];
#pragma unroll
      for (int q = 0; q < 2; ++q) {
        const float4 a = *(const float4*)(cw + ch + 4 * q), bq = *(const float4*)(cw + 1536 + ch + 4 * q), c4 = *(const float4*)(cw + 3072 + ch + 4 * q);
        w0[4 * q] = a.x; w0[4 * q + 1] = a.y; w0[4 * q + 2] = a.z; w0[4 * q + 3] = a.w;
        w1[4 * q] = bq.x; w1[4 * q + 1] = bq.y; w1[4 * q + 2] = bq.z; w1[4 * q + 3] = bq.w;
        w2[4 * q] = c4.x; w2[4 * q + 1] = c4.y; w2[4 * q + 2] = c4.z; w2[4 * q + 3] = c4.w;
      }
      const bf16_t* pr = P + (size_t)row0 * PLD + P_CQ + ch;
      const u32x4 z = mk4(0u, 0u, 0u, 0u);
      const bool hp = (t0 != 0 && t0 != CTX), hn = (t0 + 15 != CTX - 1 && t0 + 15 != TT - 1);
      u32x4 up = hp ? *(const u32x4*)(pr - PLD) : z;
      u32x4 uc = *(const u32x4*)pr;
      const float nsc = ph < 4 ? 0.08838834764831845f : 1.f;
#pragma unroll 4
      for (int rr = 0; rr < 16; ++rr) {
        const bool has = rr < 15 || hn;
        const u32x4 un = has ? *(const u32x4*)(pr + (size_t)(rr + 1) * PLD) : z;
        float fc[8], fp[8], fn[8], y[8];
        unpack8(uc, fc); unpack8(up, fp); unpack8(un, fn);
        float ss = 0.f;
#pragma unroll
        for (int e = 0; e < 8; ++e) { y[e] = siluf_(w0[e] * fp[e] + w1[e] * fc[e] + w2[e] * fn[e]); ss += y[e] * y[e]; }
        ss += dpp_xor1(ss);
        ss += dpp_xor2(ss);
        ss += __shfl_xor(ss, 4);
        ss += __shfl_xor(ss, 8);
        const float sc = ph < 8 ? rsqrtf(ss + 1e-6f) * nsc : 1.f;
        *(u32x4*)(cq + (size_t)(row0 + rr) * 1536 + ch) = mk4(pk2(y[0] * sc, y[1] * sc), pk2(y[2] * sc, y[3] * sc), pk2(y[4] * sc, y[5] * sc), pk2(y[6] * sc, y[7] * sc));
        up = uc; uc = un;
      }
    }
  }
}

DI void attn_item(const Params& p, int item, char* smem) {
  const bf16_t* P = (const bf16_t*)(p.ws + OFF_BIG);
  const bf16_t* vt = (const bf16_t*)(p.ws + OFF_VT);
  bf16_t* Y = (bf16_t*)(p.ws + OFF_Y);
  const int tid = tid_(), lane = tid & 63, wave = tid >> 6, h = lane >> 5, l31 = lane & 31;
  int b, head, qrow0, nkeys;
  if (item < 1024) { b = item >> 7; head = (item >> 4) & 7; qrow0 = b * TT + CTX + (item & 15) * 128; nkeys = TT; }
  else { int it = item - 1024; b = it >> 4; head = (it >> 1) & 7; qrow0 = b * TT + (it & 1) * 128; nkeys = CTX; }
  const int kvh = head >> 2;
  const int qrow = qrow0 + wave * 32 + l31;
  bf16x8 qf[4];
#pragma unroll
  for (int s = 0; s < 4; ++s) qf[s] = *(const bf16x8*)(P + (size_t)qrow * PLD + P_BQ + head * 64 + s * 16 + 8 * h);
  f32x16 O[2];
#pragma unroll
  for (int i = 0; i < 16; ++i) { O[0][i] = 0.f; O[1][i] = 0.f; }
  float m = -1e30f, lsum = 0.f;
  constexpr int KVB = 64 * 144 + 64 * 136;
  const bf16_t* kbase = P + (size_t)(b * TT) * PLD + P_BK + kvh * 64;
  const bf16_t* vbase = vt + (size_t)(b * 2 + kvh) * 64 * TT;
  u32x4 kr[2], vr[2];
  const int ntiles = nkeys >> 6;
  auto kvload = [&](int key0) {
#pragma unroll
    for (int i = 0; i < 2; ++i) {
      int cid = tid + 256 * i, r = cid >> 3, cc = cid & 7;
      kr[i] = *(const u32x4*)(kbase + (size_t)(key0 + r) * PLD + cc * 8);
      vr[i] = *(const u32x4*)(vbase + (size_t)r * TT + key0 + cc * 8);
    }
  };
  auto kvwrite = [&](int buf) {
    char* bK = smem + buf * KVB;
    char* bV = bK + 64 * 144;
#pragma unroll
    for (int i = 0; i < 2; ++i) {
      int cid = tid + 256 * i, r = cid >> 3, cc = cid & 7;
      *(u32x4*)(bK + r * 144 + cc * 16) = kr[i];
      *(u32x2*)(bV + r * 136 + cc * 16) = mk2(vr[i].x, vr[i].y);
      *(u32x2*)(bV + r * 136 + cc * 16 + 8) = mk2(vr[i].z, vr[i].w);
    }
  };
  kvload(0);
  __syncthreads();
  kvwrite(0);
  if (ntiles > 1) kvload(64);
  __syncthreads();
  for (int kt = 0; kt < ntiles; ++kt) {
    const char* sK = smem + (kt & 1) * KVB;
    const char* sV = sK + 64 * 144;
    if (kt + 1 < ntiles) {
      kvwrite((kt + 1) & 1);
      if (kt + 2 < ntiles) kvload((kt + 2) * 64);
    }
    f32x16 X[2];
#pragma unroll
    for (int k2 = 0; k2 < 2; ++k2) {
#pragma unroll
      for (int i = 0; i < 16; ++i) X[k2][i] = 0.f;
#pragma unroll
      for (int s = 0; s < 4; ++s) {
        bf16x8 kf = *(const bf16x8*)(sK + (k2 * 32 + l31) * 144 + s * 32 + h * 16);
        X[k2] = __builtin_amdgcn_mfma_f32_32x32x16_bf16(kf, qf[s], X[k2], 0, 0, 0);
      }
    }
    float mx = X[0][0];
#pragma unroll
    for (int i = 0; i < 16; ++i) { mx = fmaxf(mx, X[0][i]); mx = fmaxf(mx, X[1][i]); }
    mx = fmaxf(mx, __shfl_xor(mx, 32));
    const float mnew = fmaxf(m, mx);
    const float alpha = __builtin_amdgcn_exp2f(m - mnew);
    m = mnew;
    float ps = 0.f;
#pragma unroll
    for (int k2 = 0; k2 < 2; ++k2)
#pragma unroll
      for (int i = 0; i < 16; ++i) { float e = __builtin_amdgcn_exp2f(X[k2][i] - mnew); X[k2][i] = e; ps += e; }
    lsum = lsum * alpha + ps;
#pragma unroll
    for (int i = 0; i < 16; ++i) { O[0][i] *= alpha; O[1][i] *= alpha; }
#pragma unroll
    for (int k2 = 0; k2 < 2; ++k2)
#pragma unroll
      for (int s2 = 0; s2 < 2; ++s2) {
        u32x4 pu = mk4(pk2(X[k2][8 * s2 + 0], X[k2][8 * s2 + 1]), pk2(X[k2][8 * s2 + 2], X[k2][8 * s2 + 3]),
                              pk2(X[k2][8 * s2 + 4], X[k2][8 * s2 + 5]), pk2(X[k2][8 * s2 + 6], X[k2][8 * s2 + 7]));
        bf16x8 pf = __builtin_bit_cast(bf16x8, pu);
#pragma unroll
        for (int dt = 0; dt < 2; ++dt) {
          const char* va = sV + (dt * 32 + l31) * 136 + (k2 * 32 + 16 * s2 + 4 * h) * 2;
          u32x2 v0 = *(const u32x2*)va, v1 = *(const u32x2*)(va + 16);
          bf16x8 vf = __builtin_bit_cast(bf16x8, mk4(v0.x, v0.y, v1.x, v1.y));
          O[dt] = __builtin_amdgcn_mfma_f32_32x32x16_bf16(vf, pf, O[dt], 0, 0, 0);
        }
      }
    __syncthreads();
  }
  lsum += __shfl_xor(lsum, 32);
  const float inv = 1.f / lsum;
  bf16_t* yr = Y + (size_t)qrow * 1536 + 512 + head * 64;
#pragma unroll
  for (int dt = 0; dt < 2; ++dt)
#pragma unroll
    for (int g = 0; g < 4; ++g) {
      const int d = dt * 32 + 8 * g + 4 * h;
      *(u32x2*)(yr + d) = mk2(pk2(O[dt][4 * g] * inv, O[dt][4 * g + 1] * inv), pk2(O[dt][4 * g + 2] * inv, O[dt][4 * g + 3] * inv));
    }
}

DI void mlstm_chunk_item(const Params& p, int item, char* smem) {
  const bf16_t* P = (const bf16_t*)(p.ws + OFF_BIG);
  const float* aux = (const float*)(p.ws + OFF_AUX);
  const int tid = tid_(), lane = tid & 63, w = tid >> 6, h = lane >> 5, l31 = lane & 31;
  const int dir = item & 1, hh = (item >> 1) & 3, b = item >> 3;
  bf16_t* ob = (bf16_t*)(p.ws + OFF_HSA) + (size_t)dir * M * 512;
  char* sQ = smem; char* sK = smem + 9216; char* sKt = smem + 18432; char* sVt = smem + 27648;
  float* sbc = (float*)(smem + 46080); float* su = sbc + 64; float* sgm = su + 64; float* sn = sgm + 64;
  const f32x16 z16 = {0.f, 0.f, 0.f, 0.f, 0.f, 0.f, 0.f, 0.f, 0.f, 0.f, 0.f, 0.f, 0.f, 0.f, 0.f, 0.f};
  f32x16 C0 = z16, C1 = z16;
  float m = -1e30f;
  __syncthreads();
  if (tid < 64) sn[tid] = 0.f;
  u32x4 rq[2], rk[2], rv[4];
  float ru = 0.f, rg63 = 0.f, ra0 = 0.f, ra1 = 0.f, ra2 = 0.f;
  const int aoff = (dir * 4 + hh) * 3;
  auto gload = [&](int k) {
    const int c = dir ? (k < 4 ? 3 - k : 39 - k) : k;
    const size_t row0 = (size_t)b * TT + c * 64;
    const int j = tid & 63, c0 = tid >> 6;
    const bf16_t* pr = P + (row0 + j) * PLD;
#pragma unroll
    for (int i = 0; i < 2; ++i) {
      rq[i] = *(const u32x4*)(pr + P_AQ + hh * 64 + (c0 + 4 * i) * 8);
      rk[i] = *(const u32x4*)(pr + P_AK + hh * 64 + (c0 + 4 * i) * 8);
    }
#pragma unroll
    for (int i = 0; i < 4; ++i) rv[i] = *(const u32x4*)(pr + P_AV + hh * 128 + (c0 + 4 * i) * 8);
    ru = aux[(row0 + j) * 32 + aoff + 1];
    rg63 = aux[(row0 + (dir ? 0 : 63)) * 32 + aoff + 2];
    if (tid < 64) {
      const float* ar = aux + (row0 + (dir ? 63 - tid : tid)) * 32 + aoff;
      ra0 = ar[0]; ra1 = ar[1]; ra2 = ar[2];
    }
  };
  gload(0);
#pragma unroll 1
  for (int k = 0; k < 36; ++k) {
    const int c = dir ? (k < 4 ? 3 - k : 39 - k) : k;
    const size_t row0 = (size_t)b * TT + c * 64;
    __syncthreads();
    {
      const int j = tid & 63, pp = dir ? 63 - j : j, c0 = tid >> 6;
      const float ksc = __expf(ru - rg63);
      float f[8];
#pragma unroll
      for (int i = 0; i < 2; ++i) {
        const int cc = c0 + 4 * i;
        unpack8(rq[i], f);
        *(u32x4*)(sQ + pp * 144 + cc * 16) = mk4(pk2(f[0] * 0.125f, f[1] * 0.125f), pk2(f[2] * 0.125f, f[3] * 0.125f), pk2(f[4] * 0.125f, f[5] * 0.125f), pk2(f[6] * 0.125f, f[7] * 0.125f));
        *(u32x4*)(sK + pp * 144 + cc * 16) = rk[i];
        unpack8(rk[i], f);
#pragma unroll
        for (int x = 0; x < 8; ++x) *(bf16_t*)(sKt + (cc * 8 + x) * 144 + pp * 2) = f2bf(f[x] * ksc);
      }
#pragma unroll
      for (int i = 0; i < 4; ++i) {
        const int cc = c0 + 4 * i;
        const unsigned wv[4] = {rv[i].x, rv[i].y, rv[i].z, rv[i].w};
#pragma unroll
        for (int x = 0; x < 4; ++x) {
          *(bf16_t*)(sVt + (cc * 8 + 2 * x) * 144 + pp * 2) = (bf16_t)(wv[x] & 0xffffu);
          *(bf16_t*)(sVt + (cc * 8 + 2 * x + 1) * 144 + pp * 2) = (bf16_t)(wv[x] >> 16);
        }
      }
      if (tid < 64) { sbc[tid] = ra0; su[tid] = ra1; sgm[tid] = ra2; }
    }
    __syncthreads();
    if (k + 1 < 36) gload(k + 1);
#pragma unroll 1
    for (int tt = 0; tt < 2; ++tt) {
      const float gmt = sgm[tt * 32 + l31], bct = sbc[tt * 32 + l31];
      float den1 = 0.f;
      f32x16 O1 = z16;
#pragma unroll
      for (int st = 0; st <= tt; ++st) {
        f32x16 X = z16;
#pragma unroll
        for (int ks = 0; ks < 4; ++ks) {
          bf16x8 af = *(const bf16x8*)(sK + (st * 32 + l31) * 144 + ks * 32 + h * 16);
          bf16x8 bq = *(const bf16x8*)(sQ + (tt * 32 + l31) * 144 + ks * 32 + h * 16);
          X = __builtin_amdgcn_mfma_f32_32x32x16_bf16(af, bq, X, 0, 0, 0);
        }
#pragma unroll
        for (int i = 0; i < 16; ++i) {
          const int sl = (i & 3) + 8 * (i >> 2) + 4 * h;
          const float e = __expf(su[st * 32 + sl] - gmt);
          const bool ok = (st < tt) || (sl <= l31);
          const float v = ok ? X[i] * e : 0.f;
          X[i] = v;
          den1 += v;
        }
#pragma unroll
        for (int s2 = 0; s2 < 2; ++s2) {
          bf16x8 pf = __builtin_bit_cast(bf16x8, mk4(pk2(X[8 * s2], X[8 * s2 + 1]), pk2(X[8 * s2 + 2], X[8 * s2 + 3]), pk2(X[8 * s2 + 4], X[8 * s2 + 5]), pk2(X[8 * s2 + 6], X[8 * s2 + 7])));
          const char* va = sVt + (32 * w + l31) * 144 + (st * 32 + 16 * s2 + 4 * h) * 2;
          u32x2 v0 = *(const u32x2*)va, v1 = *(const u32x2*)(va + 16);
          bf16x8 vf = __builtin_bit_cast(bf16x8, mk4(v0.x, v0.y, v1.x, v1.y));
          O1 = __builtin_amdgcn_mfma_f32_32x32x16_bf16(vf, pf, O1, 0, 0, 0);
        }
      }
      __builtin_amdgcn_sched_barrier(0);
      f32x16 O2 = z16;
#pragma unroll
      for (int dt = 0; dt < 2; ++dt)
#pragma unroll
        for (int s2 = 0; s2 < 2; ++s2) {
          bf16x8 cf;
          if (dt == 0) cf = __builtin_bit_cast(bf16x8, mk4(pk2(C0[8 * s2], C0[8 * s2 + 1]), pk2(C0[8 * s2 + 2], C0[8 * s2 + 3]), pk2(C0[8 * s2 + 4], C0[8 * s2 + 5]), pk2(C0[8 * s2 + 6], C0[8 * s2 + 7])));
          else cf = __builtin_bit_cast(bf16x8, mk4(pk2(C1[8 * s2], C1[8 * s2 + 1]), pk2(C1[8 * s2 + 2], C1[8 * s2 + 3]), pk2(C1[8 * s2 + 4], C1[8 * s2 + 5]), pk2(C1[8 * s2 + 6], C1[8 * s2 + 7])));
          const char* qa = sQ + (tt * 32 + l31) * 144 + (dt * 32 + 16 * s2 + 4 * h) * 2;
          u32x2 q0 = *(const u32x2*)qa, q1 = *(const u32x2*)(qa + 16);
          bf16x8 qf = __builtin_bit_cast(bf16x8, mk4(q0.x, q0.y, q1.x, q1.y));
          O2 = __builtin_amdgcn_mfma_f32_32x32x16_bf16(cf, qf, O2, 0, 0, 0);
        }
      __builtin_amdgcn_sched_barrier(0);
      float acc = 0.f;
#pragma unroll
      for (int q4 = 0; q4 < 4; ++q4) {
        u32x4 qv = *(const u32x4*)(sQ + (tt * 32 + l31) * 144 + (32 * h + 8 * q4) * 2);
        float f[8];
        unpack8(qv, f);
        float4 n0 = *(const float4*)(sn + 32 * h + 8 * q4), n1 = *(const float4*)(sn + 32 * h + 8 * q4 + 4);
        acc += f[0] * n0.x + f[1] * n0.y + f[2] * n0.z + f[3] * n0.w + f[4] * n1.x + f[5] * n1.y + f[6] * n1.z + f[7] * n1.w;
      }
      const float den2 = acc + __shfl_xor(acc, 32);
      den1 += __shfl_xor(den1, 32);
      const float mx = fmaxf(m, gmt);
      const float fa = __expf(gmt - mx), fb = __expf(m - mx);
      const float den = fa * den1 + fb * den2;
      const float inv = 1.f / fmaxf(fabsf(den), __expf(-(bct + mx)));
      const float fai = fa * inv, fbi = fb * inv;
      const int pp = tt * 32 + l31, j = dir ? 63 - pp : pp;
      bf16_t* orow = ob + (row0 + j) * 512 + hh * 128 + 32 * w + 4 * h;
#pragma unroll
      for (int g = 0; g < 4; ++g) {
        const float v0 = fai * O1[4 * g] + fbi * O2[4 * g], v1 = fai * O1[4 * g + 1] + fbi * O2[4 * g + 1];
        const float v2 = fai * O1[4 * g + 2] + fbi * O2[4 * g + 2], v3 = fai * O1[4 * g + 3] + fbi * O2[4 * g + 3];
        *(u32x2*)(orow + 8 * g) = mk2(pk2(v0, v1), pk2(v2, v3));
      }
    }
    __builtin_amdgcn_sched_barrier(0);
    const float gm63 = sgm[63], bc63 = sbc[63];
    const float mx63 = fmaxf(m, gm63);
    const float dcy = __expf(m - mx63), fs = __expf(gm63 - mx63);
#pragma unroll
    for (int dt = 0; dt < 2; ++dt) {
      f32x16 Cn = z16;
#pragma unroll
      for (int ss = 0; ss < 4; ++ss) {
        bf16x8 ka = *(const bf16x8*)(sKt + (dt * 32 + l31) * 144 + ss * 32 + h * 16);
        bf16x8 vb = *(const bf16x8*)(sVt + (32 * w + l31) * 144 + ss * 32 + h * 16);
        Cn = __builtin_amdgcn_mfma_f32_32x32x16_bf16(ka, vb, Cn, 0, 0, 0);
      }
      if (dt == 0) C0 = C0 * dcy + Cn * fs; else C1 = C1 * dcy + Cn * fs;
    }
    __syncthreads();
    if (tid < 64) {
      float acc = 0.f;
#pragma unroll
      for (int q8 = 0; q8 < 8; ++q8) {
        u32x4 kv = *(const u32x4*)(sKt + tid * 144 + q8 * 16);
        float f[8];
        unpack8(kv, f);
        acc += ((f[0] + f[1]) + (f[2] + f[3])) + ((f[4] + f[5]) + (f[6] + f[7]));
      }
      sn[tid] = dcy * sn[tid] + fs * acc;
    }
    m = bc63 + mx63;
  }
  __syncthreads();
}


DI void gdn_pre_item(const Params& p, int item, char* smem) {
  const bf16_t* cq = (const bf16_t*)(p.ws + OFF_ACT);
  const float* aux = (const float*)(p.ws + OFF_AUX);
  const float* gates = (const float*)(p.ws + OFF_GATES);
  bf16_t* P = (bf16_t*)(p.ws + OFF_BIG);
  bf16_t* Y = (bf16_t*)(p.ws + OFF_Y);
  const int tid = tid_(), lane = tid & 63, w = tid >> 6, h = lane >> 5, l31 = lane & 31;
  const int dir = item & 1, hh = (item >> 1) & 3, cb = item >> 3;
  const int b = cb / 36, c = cb - b * 36;
  const size_t row0 = (size_t)b * TT + c * 64;
  char* sK = smem; char* sQ = smem + 17408; char* sV = smem + 34816;
  float* sA = (float*)(smem + 52224);
  float* sG = (float*)(smem + 69632); float* sB = sG + 64;
  __syncthreads();
  {
    const int j = tid & 63, pp = dir ? 63 - j : j, c0 = tid >> 6;
    const bf16_t* src = cq + (row0 + j) * 1536 + hh * 128;
#pragma unroll 2
    for (int i = 0; i < 4; ++i) {
      const int cc = c0 + 4 * i;
      *(u32x4*)(sQ + pp * 272 + cc * 16) = *(const u32x4*)(src + cc * 8);
      *(u32x4*)(sK + pp * 272 + cc * 16) = *(const u32x4*)(src + 512 + cc * 8);
      *(u32x4*)(sV + pp * 272 + cc * 16) = *(const u32x4*)(src + 1024 + cc * 8);
    }
    if (tid < 64) {
      const size_t r = row0 + (dir ? 63 - tid : tid);
      sG[tid] = aux[r * 32 + 24 + dir * 4 + hh];
      sB[tid] = gates[r * 32 + 24 + dir * 4 + hh];
    }
  }
  __syncthreads();
#pragma unroll 1
  for (int job = w; job < 6; job += 4) {
    const int isq = job >= 3, tl = isq ? job - 3 : job;
    const int rt = tl == 0 ? 0 : 1, ct = tl == 2 ? 1 : 0;
    const char* abase = (isq ? sQ : sK) + (rt * 32 + l31) * 272 + h * 16;
    const char* bbase = sK + (ct * 32 + l31) * 272 + h * 16;
    f32x16 X = {0.f, 0.f, 0.f, 0.f, 0.f, 0.f, 0.f, 0.f, 0.f, 0.f, 0.f, 0.f, 0.f, 0.f, 0.f, 0.f};
#pragma unroll
    for (int ks = 0; ks < 8; ++ks) {
      bf16x8 af = *(const bf16x8*)(abase + ks * 32), bfr = *(const bf16x8*)(bbase + ks * 32);
      X = __builtin_amdgcn_mfma_f32_32x32x16_bf16(af, bfr, X, 0, 0, 0);
    }
    const int cidx = ct * 32 + l31;
    const float gc = sG[cidx];
#pragma unroll
    for (int i = 0; i < 16; ++i) {
      const int rl = (i & 3) + 8 * (i >> 2) + 4 * h, r = rt * 32 + rl;
      const float gr = sG[r];
      if (!isq) {
        const bool ok = (rt > ct) || (l31 < rl);
        sA[r * 68 + cidx] = ok ? X[i] * __expf(gr - gc) * sB[r] : 0.f;
      } else {
        const bool ok = (rt > ct) || (l31 <= rl);
        const float v = ok ? X[i] * __expf(gr - gc) : 0.f;
        Y[(row0 + (dir ? 63 - r : r)) * 1536 + 1024 + dir * 256 + hh * 64 + cidx] = f2bf(v);
      }
    }
  }
  __syncthreads();
  {
    const int cidx = tid & 127;
    const bool isw = tid >= 128;
    const char* bsrc = (isw ? sK : sV) + cidx * 2;
    float x[64];
#pragma unroll
    for (int t = 0; t < 64; ++t) x[t] = 0.f;
    bf16_t* wp = dir ? Y + (row0 + 63) * 1536 + hh * 128 + cidx : P + row0 * PLD + P_CQ + 1024 + hh * 128 + cidx;
    const long wstep = dir ? -1536 : PLD;
#pragma unroll
    for (int t = 0; t < 64; ++t) {
      const float g = sG[t], be = sB[t];
      float acc = bf2f(*(const bf16_t*)(bsrc + t * 272)) * (isw ? be * __expf(g) : be);
      float acc1 = 0.f, acc2 = 0.f, acc3 = 0.f;
#pragma unroll
      for (int s4 = 0; s4 < (t + 3) / 4; ++s4) {
        const float4 a = *(const float4*)(sA + t * 68 + 4 * s4);
        acc -= a.x * x[4 * s4];
        acc1 -= a.y * x[4 * s4 + 1];
        acc2 -= a.z * x[4 * s4 + 2];
        acc3 -= a.w * x[4 * s4 + 3];
      }
      acc = (acc + acc1) + (acc2 + acc3);
      x[t] = acc;
      __builtin_amdgcn_sched_barrier(0);
      if (isw) *wp = f2bf(-acc);
      wp += wstep;
      asm volatile("" : "+v"(wp));
    }
    if (!isw) {
      bf16_t* ud = P + (row0 + (cidx >> 1)) * PLD + P_CQ + dir * 512 + hh * 128 + (cidx & 1) * 64;
#pragma unroll
      for (int q = 0; q < 8; ++q)
        *(u32x4*)(ud + 8 * q) = mk4(pk2(x[8 * q], x[8 * q + 1]), pk2(x[8 * q + 2], x[8 * q + 3]), pk2(x[8 * q + 4], x[8 * q + 5]), pk2(x[8 * q + 6], x[8 * q + 7]));
    }
  }
}

DI void gdn_chunk_item(const Params& p, int item, char* smem) {
  const bf16_t* cq = (const bf16_t*)(p.ws + OFF_ACT);
  const float* aux = (const float*)(p.ws + OFF_AUX);
  const bf16_t* P = (const bf16_t*)(p.ws + OFF_BIG);
  const bf16_t* Y = (const bf16_t*)(p.ws + OFF_Y);
  const int tid = tid_(), lane = tid & 63, w = tid >> 6, h = lane >> 5, l31 = lane & 31;
  const int dir = item & 1, hh = (item >> 1) & 3, b = item >> 3;
  bf16_t* ob = (bf16_t*)(p.ws + OFF_HSC) + (size_t)dir * M * 512;
  float* sG = (float*)(smem + 65536);
  const f32x16 z16 = {0.f, 0.f, 0.f, 0.f, 0.f, 0.f, 0.f, 0.f, 0.f, 0.f, 0.f, 0.f, 0.f, 0.f, 0.f, 0.f};
  f32x16 S[4] = {z16, z16, z16, z16};
  u32x4 rk[4], rqk[2], uf[4];
  float rg = 0.f;
  const int j = tid & 63, pp = dir ? 63 - j : j, c0 = tid >> 6;
  auto row_of = [&](int k) -> size_t { const int c = dir ? (k < 4 ? 3 - k : 39 - k) : k; return (size_t)b * TT + c * 64; };
  auto dma_qw = [&](int k) {
    const size_t row0 = row_of(k);
    char* base = smem + (k & 1) * 32768;
    int ln = lane;
    asm volatile("" : "+v"(ln));
#pragma unroll
    for (int i = 0; i < 4; ++i) {
      const int grp = w + 4 * i;
      const int rpp = 4 * grp + (ln >> 4), pos = ln & 15;
      const size_t rj = row0 + (dir ? 63 - rpp : rpp);
      const int sc = pos ^ (rpp & 15);
      const bf16_t* qs = cq + rj * 1536 + hh * 128 + sc * 8;
      const bf16_t* ws_ = (dir ? Y + rj * 1536 + hh * 128 : P + rj * PLD + P_CQ + 1024 + hh * 128) + sc * 8;
      __builtin_amdgcn_global_load_lds((const unsigned*)qs, (__attribute__((address_space(3))) unsigned*)(base + grp * 1024), 16, 0, 0);
      __builtin_amdgcn_global_load_lds((const unsigned*)ws_, (__attribute__((address_space(3))) unsigned*)(base + 16384 + grp * 1024), 16, 0, 0);
    }
  };
  auto gload_r = [&](int k) {
    size_t row0 = row_of(k);
    asm volatile("" : "+v"(row0));
    const size_t rj = row0 + j;
#pragma unroll
    for (int i = 0; i < 4; ++i) rk[i] = *(const u32x4*)(cq + rj * 1536 + 512 + hh * 128 + (c0 + 4 * i) * 8);
#pragma unroll
    for (int i = 0; i < 2; ++i) rqk[i] = *(const u32x4*)(Y + rj * 1536 + 1024 + dir * 256 + hh * 64 + (c0 + 4 * i) * 8);
    if (tid < 64) rg = aux[(row0 + (dir ? 63 - tid : tid)) * 32 + 24 + dir * 4 + hh];
    const int e = 32 * w + l31;
    const bf16_t* us = P + (row0 + (e >> 1)) * PLD + P_CQ + dir * 512 + hh * 128 + (e & 1) * 64 + 8 * h;
#pragma unroll
    for (int ks = 0; ks < 4; ++ks) uf[ks] = *(const u32x4*)(us + 16 * ks);
  };
  __syncthreads();
  dma_qw(0);
  gload_r(0);
  if (tid < 64) sG[tid] = rg;
  const int sw16 = (l31 & 15) << 4;
#pragma unroll 1
  for (int k = 0; k < 36; ++k) {
    const size_t row0 = row_of(k);
    char* bufc = smem + (k & 1) * 32768;
    const float* sGc = sG + (k & 1) * 64;
    f32x16 X[2];
#pragma unroll
    for (int st = 0; st < 2; ++st) {
      X[st] = z16;
#pragma unroll
      for (int kk = 0; kk < 2; ++kk) {
        const int j0 = l31 - 16 * kk - 8 * h;
        unsigned idw[4];
#pragma unroll
        for (int q = 0; q < 4; ++q) idw[q] = (j0 == 2 * q) ? 0x00003F80u : ((j0 == 2 * q + 1) ? 0x3F800000u : 0u);
        X[st] = __builtin_amdgcn_mfma_f32_32x32x16_bf16(__builtin_bit_cast(bf16x8, mk4(idw[0], idw[1], idw[2], idw[3])), __builtin_bit_cast(bf16x8, uf[2 * st + kk]), X[st], 0, 0, 0);
      }
    }
    __syncthreads();
    if (k + 1 < 36) dma_qw(k + 1);
    __builtin_amdgcn_sched_barrier(0);
    f32x16 O[2] = {z16, z16};
#pragma unroll
    for (int dq = 0; dq < 4; ++dq)
#pragma unroll
      for (int s2 = 0; s2 < 2; ++s2) {
        const bf16x8 sf = __builtin_bit_cast(bf16x8, mk4(pk2(S[dq][8 * s2], S[dq][8 * s2 + 1]), pk2(S[dq][8 * s2 + 2], S[dq][8 * s2 + 3]),
                                                         pk2(S[dq][8 * s2 + 4], S[dq][8 * s2 + 5]), pk2(S[dq][8 * s2 + 6], S[dq][8 * s2 + 7])));
        const int cb = (4 * dq + 2 * s2) << 4;
        const int o0 = (cb ^ sw16) + 8 * h, o1 = ((cb + 16) ^ sw16) + 8 * h;
#pragma unroll
        for (int st = 0; st < 2; ++st) {
          const char* a = bufc + 16384 + (st * 32 + l31) * 256;
          const u32x2 a0 = *(const u32x2*)(a + o0), a1 = *(const u32x2*)(a + o1);
          X[st] = __builtin_amdgcn_mfma_f32_32x32x16_bf16(__builtin_bit_cast(bf16x8, mk4(a0.x, a0.y, a1.x, a1.y)), sf, X[st], 0, 0, 0);
        }
#pragma unroll
        for (int tt = 0; tt < 2; ++tt) {
          const char* a = bufc + (tt * 32 + l31) * 256;
          const u32x2 a0 = *(const u32x2*)(a + o0), a1 = *(const u32x2*)(a + o1);
          O[tt] = __builtin_amdgcn_mfma_f32_32x32x16_bf16(__builtin_bit_cast(bf16x8, mk4(a0.x, a0.y, a1.x, a1.y)), sf, O[tt], 0, 0, 0);
        }
      }
    __builtin_amdgcn_sched_barrier(0);
#pragma unroll
    for (int tt = 0; tt < 2; ++tt)
#pragma unroll
      for (int i = 0; i < 16; ++i) O[tt][i] *= __expf(sGc[tt * 32 + (i & 3) + 8 * (i >> 2) + 4 * h]);
    asm volatile("s_waitcnt lgkmcnt(0)" ::: "memory");
    __builtin_amdgcn_s_barrier();
    {
      char* sKt = bufc; char* sQK = bufc + 18432;
#pragma unroll
      for (int i = 0; i < 4; ++i) {
        const int cc = c0 + 4 * i;
        const unsigned kw[4] = {rk[i].x, rk[i].y, rk[i].z, rk[i].w};
#pragma unroll
        for (int x = 0; x < 4; ++x) {
          *(bf16_t*)(sKt + (cc * 8 + 2 * x) * 144 + pp * 2) = (bf16_t)(kw[x] & 0xffffu);
          *(bf16_t*)(sKt + (cc * 8 + 2 * x + 1) * 144 + pp * 2) = (bf16_t)(kw[x] >> 16);
        }
      }
#pragma unroll
      for (int i = 0; i < 2; ++i) {
        const int cc = c0 + 4 * i;
        *(u32x2*)(sQK + pp * 136 + cc * 16) = mk2(rqk[i].x, rqk[i].y);
        *(u32x2*)(sQK + pp * 136 + cc * 16 + 8) = mk2(rqk[i].z, rqk[i].w);
      }
    }
    asm volatile("s_waitcnt lgkmcnt(0)" ::: "memory");
    __builtin_amdgcn_s_barrier();
    __builtin_amdgcn_sched_barrier(0);
    {
      const char* sQK = bufc + 18432;
#pragma unroll
      for (int st = 0; st < 2; ++st)
#pragma unroll
        for (int s2 = 0; s2 < 2; ++s2) {
          const bf16x8 vf = __builtin_bit_cast(bf16x8, mk4(pk2(X[st][8 * s2], X[st][8 * s2 + 1]), pk2(X[st][8 * s2 + 2], X[st][8 * s2 + 3]),
                                                           pk2(X[st][8 * s2 + 4], X[st][8 * s2 + 5]), pk2(X[st][8 * s2 + 6], X[st][8 * s2 + 7])));
#pragma unroll
          for (int tt = st; tt < 2; ++tt) {
            const char* a = sQK + (tt * 32 + l31) * 136 + (st * 32 + 16 * s2 + 4 * h) * 2;
            const u32x2 a0 = *(const u32x2*)a, a1 = *(const u32x2*)(a + 16);
            O[tt] = __builtin_amdgcn_mfma_f32_32x32x16_bf16(__builtin_bit_cast(bf16x8, mk4(a0.x, a0.y, a1.x, a1.y)), vf, O[tt], 0, 0, 0);
          }
        }
    }
    {
      bf16_t* obase = ob + (row0 + (dir ? 63 - 4 * h : 4 * h)) * 512 + hh * 128 + 32 * w + l31;
      asm volatile("" : "+v"(obase));
#pragma unroll
      for (int tt = 0; tt < 2; ++tt)
#pragma unroll
        for (int i = 0; i < 16; ++i) {
          const int tq = tt * 32 + (i & 3) + 8 * (i >> 2);
          if (dir) *(obase - tq * 512) = f2bf(O[tt][i]); else *(obase + tq * 512) = f2bf(O[tt][i]);
        }
    }
    __builtin_amdgcn_sched_barrier(0);
    if (k + 1 < 36) {
      gload_r(k + 1);
    }
    __builtin_amdgcn_sched_barrier(0);
    const float g63 = sGc[63], eg63 = __expf(g63);
#pragma unroll
    for (int st = 0; st < 2; ++st)
#pragma unroll
      for (int i = 0; i < 16; ++i) X[st][i] *= __expf(g63 - sGc[st * 32 + (i & 3) + 8 * (i >> 2) + 4 * h]);
#pragma unroll
    for (int dq = 0; dq < 4; ++dq) S[dq] = S[dq] * eg63;
    {
      const char* sKt = bufc;
#pragma unroll
      for (int st = 0; st < 2; ++st)
#pragma unroll
        for (int s2 = 0; s2 < 2; ++s2) {
          const bf16x8 vf = __builtin_bit_cast(bf16x8, mk4(pk2(X[st][8 * s2], X[st][8 * s2 + 1]), pk2(X[st][8 * s2 + 2], X[st][8 * s2 + 3]),
                                                           pk2(X[st][8 * s2 + 4], X[st][8 * s2 + 5]), pk2(X[st][8 * s2 + 6], X[st][8 * s2 + 7])));
#pragma unroll
          for (int dq = 0; dq < 4; ++dq) {
            const char* a = sKt + (dq * 32 + l31) * 144 + (st * 32 + 16 * s2 + 4 * h) * 2;
            const u32x2 a0 = *(const u32x2*)a, a1 = *(const u32x2*)(a + 16);
            S[dq] = __builtin_amdgcn_mfma_f32_32x32x16_bf16(__builtin_bit_cast(bf16x8, mk4(a0.x, a0.y, a1.x, a1.y)), vf, S[dq], 0, 0, 0);
          }
        }
    }
    if (k + 1 < 36 && tid < 64) sG[((k + 1) & 1) * 64 + tid] = rg;
  }
  __syncthreads();
}

DI void post_phase(const Params& p, int l, bool skip_ctx) {
  const bf16_t* P = (const bf16_t*)(p.ws + OFF_BIG);
  const bf16_t* oa = (const bf16_t*)(p.ws + OFF_HSA);
  const bf16_t* oc = (const bf16_t*)(p.ws + OFF_HSC);
  bf16_t* Y = (bf16_t*)(p.ws + OFF_Y);
  const int total = M * 128;
#pragma unroll 2
  for (int idx = bid_() * 256 + tid_(); idx < total; idx += gridDim.x * 256) {
    const int row = idx >> 7, r = idx & 127, br = r >> 6, hh = (r >> 4) & 3, ck = r & 15;
    if (skip_ctx && (row % TT) < CTX) continue;
    const int col = hh * 128 + ck * 8;
    const bf16_t* ob = (br ? oc : oa) + (size_t)row * 512 + col;
    float a0[8], a1[8], gt[8], v[8];
    unpack8(*(const u32x4*)ob, a0);
    unpack8(*(const u32x4*)(ob + (size_t)M * 512), a1);
    unpack8(*(const u32x4*)(P + (size_t)row * PLD + (br ? P_CZ : P_AO) + col), gt);
    float ss = 0.f;
#pragma unroll
    for (int e = 0; e < 8; ++e) { v[e] = a0[e] + a1[e]; ss += v[e] * v[e]; }
    ss += dpp_xor1(ss);
    ss += dpp_xor2(ss);
    ss += __shfl_xor(ss, 4);
    ss += __shfl_xor(ss, 8);
    const float rstd = rsqrtf(ss * (1.f / 128.f) + 1e-6f);
    const float* nw = br ? p.c_norm_w + l * 128 + ck * 8 : p.a_norm_w + l * 512 + col;
    const float4 w0 = *(const float4*)nw, w1 = *(const float4*)(nw + 4);
    const float wv[8] = {w0.x, w0.y, w0.z, w0.w, w1.x, w1.y, w1.z, w1.w};
    float y[8];
#pragma unroll
    for (int e = 0; e < 8; ++e) y[e] = v[e] * rstd * wv[e] * (br ? siluf_(gt[e]) : sigmoidf_(gt[e]));
    *(u32x4*)(Y + (size_t)row * 1536 + (br ? 1024 : 0) + col) = mk4(pk2(y[0], y[1]), pk2(y[2], y[3]), pk2(y[4], y[5]), pk2(y[6], y[7]));
  }
}

DI void ffn_act_phase(const Params& p, int l, bool skip_ctx) {
  const bf16_t* U = (const bf16_t*)(p.ws + OFF_BIG);
  bf16_t* act = (bf16_t*)(p.ws + OFF_ACT);
  const float* fw = p.ffn_conv_w + (size_t)l * 3 * 5632;
  const int total = (M / 16) * 352;
  for (int idx = bid_() * 256 + tid_(); idx < total; idx += gridDim.x * 256) {
    const int grp = idx / 352, c0 = (idx - grp * 352) * 8;
    const int row0 = grp * 16, t0 = row0 % TT;
    if (skip_ctx && t0 < CTX) continue;
    float wa[3][8], wg[3][8];
#pragma unroll
    for (int jj = 0; jj < 3; ++jj)
#pragma unroll
      for (int q = 0; q < 2; ++q) {
        const float4 va = *(const float4*)(fw + jj * 5632 + c0 + 4 * q), vg = *(const float4*)(fw + jj * 5632 + DFF + c0 + 4 * q);
        wa[jj][4 * q] = va.x; wa[jj][4 * q + 1] = va.y; wa[jj][4 * q + 2] = va.z; wa[jj][4 * q + 3] = va.w;
        wg[jj][4 * q] = vg.x; wg[jj][4 * q + 1] = vg.y; wg[jj][4 * q + 2] = vg.z; wg[jj][4 * q + 3] = vg.w;
      }
    const bf16_t* ur = U + (size_t)row0 * 5632 + c0;
    const u32x4 z = mk4(0u, 0u, 0u, 0u);
    const bool hp = (t0 != 0 && t0 != CTX);
    const bool hn = (t0 + 15 != CTX - 1 && t0 + 15 != TT - 1);
    u32x4 pa = hp ? *(const u32x4*)(ur - 5632) : z, pg = hp ? *(const u32x4*)(ur - 5632 + DFF) : z;
    u32x4 ca = *(const u32x4*)ur, cg = *(const u32x4*)(ur + DFF);
#pragma unroll 4
    for (int rr = 0; rr < 16; ++rr) {
      const bool has = rr < 15 || hn;
      const bf16_t* un = ur + (size_t)(rr + 1) * 5632;
      const u32x4 na = has ? *(const u32x4*)un : z, ng = has ? *(const u32x4*)(un + DFF) : z;
      float fp[8], fc[8], fn[8], gp[8], gc[8], gn[8];
      unpack8(pa, fp); unpack8(ca, fc); unpack8(na, fn);
      unpack8(pg, gp); unpack8(cg, gc); unpack8(ng, gn);
      unsigned o[4];
#pragma unroll
      for (int e = 0; e < 4; ++e) {
        const float a0 = wa[0][2 * e] * fp[2 * e] + wa[1][2 * e] * fc[2 * e] + wa[2][2 * e] * fn[2 * e];
        const float a1 = wa[0][2 * e + 1] * fp[2 * e + 1] + wa[1][2 * e + 1] * fc[2 * e + 1] + wa[2][2 * e + 1] * fn[2 * e + 1];
        const float g0 = wg[0][2 * e] * gp[2 * e] + wg[1][2 * e] * gc[2 * e] + wg[2][2 * e] * gn[2 * e];
        const float g1 = wg[0][2 * e + 1] * gp[2 * e + 1] + wg[1][2 * e + 1] * gc[2 * e + 1] + wg[2][2 * e + 1] * gn[2 * e + 1];
        o[e] = pk2(a0 * siluf_(g0), a1 * siluf_(g1));
      }
      *(u32x4*)(act + (size_t)(row0 + rr) * DFF + c0) = mk4(o[0], o[1], o[2], o[3]);
      pa = ca; pg = cg; ca = na; cg = ng;
    }
  }
}

__global__ void __launch_bounds__(256, 2) hybrid_fwd(Params p) {
  __shared__ __attribute__((aligned(16))) char smem[73728];
  cg::grid_group grid = cg::this_grid();
  __shared__ u32x4 xb_words;
  if (threadIdx.x == 0) xb_words = mk4(0u, 0u, 0u, 0u);
  __syncthreads();
  (void)xcd_barrier_post((unsigned*)(p.ws + OFF_BAR), (volatile LAS unsigned*)&xb_words);
#define GBAR() do { XcdBarrier xb_; xb_.bar = (unsigned*)(p.ws + OFF_BAR); xb_.x = xb_xcc_id(); xb_.st = (volatile LAS unsigned*)&xb_words; xcd_barrier(xb_); } while (0)
  const int G = gridDim.x;
  bf16_t* wbf = (bf16_t*)(p.ws + OFF_WBF);
  bf16_t* XN = (bf16_t*)(p.ws + OFF_XN);
  bf16_t* BIG = (bf16_t*)(p.ws + OFF_BIG);
  bf16_t* Y = (bf16_t*)(p.ws + OFF_Y);
  bf16_t* ACT = (bf16_t*)(p.ws + OFF_ACT);
  float* MOD = (float*)(p.ws + OFF_MOD);
  float* GATES = (float*)(p.ws + OFF_GATES);

  for (int it = bid_(); it < 384; it += G) ada_partial(p, it, smem);
  __syncthreads();
  convert_weights(p, 0, smem);
  {
    const int tid = tid_(), bid = bid_();
    if (bid == 0) {
      float* rope = (float*)(p.ws + OFF_ROPE);
      for (int i = tid; i < 1024; i += 256) {
        int pos = i >> 4, f = i & 15;
        float inv = exp2f(-(float)f * (13.287712379549449f / 16.f));
        float ang = (float)pos * inv;
        rope[i] = cosf(ang);
        rope[1024 + i] = sinf(ang);
      }
    }
  }
  if (p.ws == nullptr) grid.sync();
  GBAR();
  {
    const float* part = (const float*)(p.ws + OFF_ACT);
    const int tid = tid_(), bid = bid_();
    for (int i = bid * 256 + tid; i < DEPTH * 9 * 6144; i += G * 256) {
      int l = i / (9 * 6144), rem = i - l * 9 * 6144;
      float s = p.ada_b[l * 6144 + rem % 6144];
#pragma unroll
      for (int kc = 0; kc < 16; ++kc) s += part[(size_t)(l * 16 + kc) * 9 * 6144 + rem];
      MOD[i] = s;
    }
  }
  GBAR();

  for (int l = 0; l < DEPTH; ++l) {
    const bool last = (l == DEPTH - 1);
    const float* modl = MOD + (size_t)l * 9 * 6144;
    if (l > 0) convert_weights(p, l, smem);
    norm_phase(p, l, 0, false);
    GBAR();
    for (int base = 0; base < 72 * 35; base += G) {
      int pm, pn;
      if (!tile_of8(base, 72, 35, pm, pn)) continue;
      f32x16 acc[4][2];
      {
        const f32x16 z = {0.f, 0.f, 0.f, 0.f, 0.f, 0.f, 0.f, 0.f, 0.f, 0.f, 0.f, 0.f, 0.f, 0.f, 0.f, 0.f};
#pragma unroll
        for (int mi = 0; mi < 4; ++mi) { acc[mi][0] = z; acc[mi][1] = z; }
      }
      gemm_big(acc, XN + (size_t)pm * 256 * 1024, 1024, wbf + W_IN + (size_t)pn * 128 * 1024, wbf + W_IN + (size_t)(pn * 128 + 64) * 1024, 1024, 1024, smem);
      if (pn < 34) {
        store_bf16_big(acc, BIG + (size_t)pm * 256 * PLD + pn * 128, PLD);
      } else {
        const int tid = tid_(), lane = tid & 63, wave = tid >> 6;
        const int wr = wave >> 1, wc = wave & 1;
        const int c = lane & 31;
        if (wc == 0) {
          float bias = 0.f, alog = 0.f;
          if (c < 16) bias = p.a_gate_b[l * 16 + c];
          else if (c < 24) { bias = p.c_dt_bias[l * 8 + c - 16]; alog = -__expf(p.c_a_log[l * 8 + c - 16]); }
#pragma unroll
          for (int mi = 0; mi < 4; ++mi)
#pragma unroll
            for (int i = 0; i < 16; ++i) {
              int r = pm * 256 + wr * 128 + mi * 32 + (i & 3) + 8 * (i >> 2) + 4 * (lane >> 5);
              float v = acc[mi][0][i] + bias, o;
              if (c < 16) o = ((c >> 2) & 1) ? logsigmoidf_(v) : v;
              else if (c < 24) o = alog * softplusf_(v);
              else o = sigmoidf_(v);
              GATES[(size_t)r * 32 + c] = o;
            }
        }
      }
    }
    GBAR();
    prep_phase(p, l, smem);
    GBAR();
    for (int it = bid_(); it < NB * 36 * 8; it += G) gdn_pre_item(p, it, smem);
    GBAR();
    {
      const int bid = bid_();
      const int nsb = G > 128 ? 128 : 0;
      for (int s = bid; s < 128; s += G) {
        if (s < 64) gdn_chunk_item(p, s, smem); else mlstm_chunk_item(p, s - 64, smem);
      }
      const int nab = G - nsb, ab = bid - nsb;
      const int nitems = last ? 1024 : 1152;
      if (ab >= 0) for (int it = ab; it < nitems; it += nab) attn_item(p, it, smem);
    }
    GBAR();
    post_phase(p, l, last);
    GBAR();
    {
      const int tl = ((G & 7) == 0) ? (bid_() & 7) * (G >> 3) + (bid_() >> 3) : bid_();
      const int nfull = (G == 512) ? 1024 : 1152;
      for (int t = tl; t < 1152 + (1152 - nfull); t += G) {
        const bool half = t >= nfull;
        const int tb = half ? nfull + ((t - nfull) >> 1) : t;
        const int hsel = half ? ((t - nfull) & 1) : 0;
        const int g = tb / 128, r = tb - g * 128;
        const int pm = g * 16 + (r & 15), pn = r >> 4;
        if (last && (pm % 18) < 2) continue;
        const bf16_t* xa = XN + (size_t)pm * 128 * 1024;
        if (!half) {
          unsigned op[2][2][8];
#pragma unroll
          for (int mi = 0; mi < 2; ++mi)
#pragma unroll
            for (int ni = 0; ni < 2; ++ni)
#pragma unroll
              for (int i = 0; i < 8; ++i) op[mi][ni][i] = 0u;
#pragma unroll 1
          for (int br = 0; br < 3; ++br) {
            unsigned yp[2][2][8];
            {
              f32x16 a2[2][2];
              zero_acc<2>(a2);
              gemm_main<2>(a2, Y + (size_t)pm * 128 * 1536 + br * 512, 1536, wbf + W_B + (size_t)(br * 1024 + pn * 128) * 512, 512, 512, smem);
#pragma unroll
              for (int mi = 0; mi < 2; ++mi)
#pragma unroll
                for (int ni = 0; ni < 2; ++ni)
#pragma unroll
                  for (int i = 0; i < 8; ++i) yp[mi][ni][i] = pk2(a2[mi][ni][2 * i], a2[mi][ni][2 * i + 1]);
            }
            __builtin_amdgcn_sched_barrier(0);
            f32x16 a1[2][2];
            zero_acc<2>(a1);
            gemm_main<2>(a1, xa, 1024, wbf + W_G + (size_t)(br * 1024 + pn * 128) * 1024, 1024, 1024, smem);
#pragma unroll
            for (int mi = 0; mi < 2; ++mi)
#pragma unroll
              for (int ni = 0; ni < 2; ++ni)
#pragma unroll
                for (int i = 0; i < 8; ++i)
                  op[mi][ni][i] = pk2(bflo(op[mi][ni][i]) + sigmoidf_(a1[mi][ni][2 * i]) * bflo(yp[mi][ni][i]),
                                      bfhi(op[mi][ni][i]) + sigmoidf_(a1[mi][ni][2 * i + 1]) * bfhi(yp[mi][ni][i]));
            __builtin_amdgcn_sched_barrier(0);
          }
          {
            const int lane = tid_() & 63, wave = tid_() >> 6, wr = wave >> 1, wc = wave & 1, odd = lane & 1;
            bf16_t* C = BIG + (size_t)pm * 128 * 1024 + pn * 128;
#pragma unroll
            for (int mi = 0; mi < 2; ++mi)
#pragma unroll
              for (int ni = 0; ni < 2; ++ni)
#pragma unroll
                for (int i = 0; i < 8; ++i) {
                  const float v0 = bflo(op[mi][ni][i]), v1 = bfhi(op[mi][ni][i]);
                  const float send = odd ? v0 : v1;
                  const float recv = dpp_xor1(send);
                  const int rr = wr * 64 + mi * 32 + ((2 * i) & 3) + 8 * ((2 * i) >> 2) + 4 * (lane >> 5) + odd;
                  const int cc = wc * 64 + ni * 32 + (lane & 31) - odd;
                  *(unsigned*)(C + (size_t)rr * 1024 + cc) = odd ? pk2(recv, v1) : pk2(v0, recv);
                }
          }
        } else {
          const int cn = pn * 128 + hsel * 64;
          f32x16 outv[2][1];
          zero_acc<1>(outv);
#pragma unroll 1
          for (int br = 0; br < 3; ++br) {
            f32x16 a1[2][1], a2[2][1];
            zero_acc<1>(a1);
            gemm_main<1>(a1, xa, 1024, wbf + W_G + (size_t)(br * 1024 + cn) * 1024, 1024, 1024, smem);
            zero_acc<1>(a2);
            gemm_main<1>(a2, Y + (size_t)pm * 128 * 1536 + br * 512, 1536, wbf + W_B + (size_t)(br * 1024 + cn) * 512, 512, 512, smem);
#pragma unroll
            for (int mi = 0; mi < 2; ++mi)
#pragma unroll
              for (int i = 0; i < 16; ++i) outv[mi][0][i] += sigmoidf_(a1[mi][0][i]) * a2[mi][0][i];
          }
          store_bf16_tile<1>(outv, BIG + (size_t)pm * 128 * 1024 + cn, 1024);
        }
      }
    }
    GBAR();
    auto resid_gemm = [&](const bf16_t* A, int lda, const bf16_t* Wt, int K, int gate_idx, bool first) {
      const int tl = ((G & 7) == 0) ? (bid_() & 7) * (G >> 3) + (bid_() >> 3) : bid_();
      const int nfull = (G == 512) ? 1024 : 1152;
      for (int t = tl; t < 1152 + (1152 - nfull); t += G) {
        const bool half = t >= nfull;
        const int tb = half ? nfull + ((t - nfull) >> 1) : t;
        const int hsel = half ? ((t - nfull) & 1) : 0;
        const int g = tb / 128, r = tb - g * 128;
        const int pm = g * 16 + (r & 15), pn = r >> 4;
        const int b = pm / 18, tt = pm - b * 18;
        if (last && tt < 2) continue;
        float* hb = tt < 2 ? (float*)(p.ws + OFF_HCTX) + (size_t)(b * CTX + tt * 128) * D : p.out + (size_t)(b * SEQ + (tt - 2) * 128) * D;
        const float* hs = !first ? hb : (tt < 2 ? p.ctx + (size_t)(b * CTX + tt * 128) * D : p.x + (size_t)(b * SEQ + (tt - 2) * 128) * D);
        const int tid = tid_(), lane = tid & 63, wave = tid >> 6;
        const int wr = wave >> 1, wc = wave & 1;
        const float* gm = modl + (tt < 2 ? 8 : b) * 6144 + gate_idx * 1024;
        if (!half) {
          f32x16 acc[2][2];
          zero_acc<2>(acc);
          gemm_main<2>(acc, A + (size_t)pm * 128 * lda, lda, Wt + (size_t)pn * 128 * K, K, K, smem);
#pragma unroll
          for (int ni = 0; ni < 2; ++ni)
#pragma unroll
            for (int mi = 0; mi < 2; ++mi)
#pragma unroll
              for (int i = 0; i < 16; ++i) {
                const int rr = wr * 64 + mi * 32 + (i & 3) + 8 * (i >> 2) + 4 * (lane >> 5);
                *(float*)(smem + rr * 528 + (wc * 64 + ni * 32 + (lane & 31)) * 4) = acc[mi][ni][i];
              }
          __syncthreads();
          {
            const int c4 = tid & 31;
            const float4 g4 = *(const float4*)(gm + pn * 128 + c4 * 4);
#pragma unroll
            for (int it = 0; it < 16; ++it) {
              const int rr = (tid >> 5) + 8 * it;
              const float4 a4 = *(const float4*)(smem + rr * 528 + c4 * 16);
              const size_t ho = (size_t)rr * D + pn * 128 + c4 * 4;
              const float4 h4 = *(const float4*)(hs + ho);
              *(float4*)(hb + ho) = make_float4(h4.x + g4.x * a4.x, h4.y + g4.y * a4.y, h4.z + g4.z * a4.z, h4.w + g4.w * a4.w);
            }
          }
          __syncthreads();
        } else {
          f32x16 acc[2][1];
          zero_acc<1>(acc);
          gemm_main<1>(acc, A + (size_t)pm * 128 * lda, lda, Wt + (size_t)(pn * 128 + hsel * 64) * K, K, K, smem);
#pragma unroll
          for (int mi = 0; mi < 2; ++mi)
#pragma unroll
            for (int i = 0; i < 16; ++i) {
              const int rr = wr * 64 + mi * 32 + (i & 3) + 8 * (i >> 2) + 4 * (lane >> 5);
              *(float*)(smem + rr * 528 + (wc * 32 + (lane & 31)) * 4) = acc[mi][0][i];
            }
          __syncthreads();
          {
            const int c4 = tid & 15, cb = pn * 128 + hsel * 64;
            const float4 g4 = *(const float4*)(gm + cb + c4 * 4);
#pragma unroll
            for (int it = 0; it < 8; ++it) {
              const int rr = (tid >> 4) + 16 * it;
              const float4 a4 = *(const float4*)(smem + rr * 528 + c4 * 16);
              const size_t ho = (size_t)rr * D + cb + c4 * 4;
              const float4 h4 = *(const float4*)(hs + ho);
              *(float4*)(hb + ho) = make_float4(h4.x + g4.x * a4.x, h4.y + g4.y * a4.y, h4.z + g4.z * a4.z, h4.w + g4.w * a4.w);
            }
          }
          __syncthreads();
        }
      }
    };
    resid_gemm(BIG, 1024, wbf + W_O, 1024, 2, l == 0);
    GBAR();
    norm_phase(p, l, 1, last);
    GBAR();
    for (int base = 0; base < 72 * 44; base += G) {
      int pm, pn;
      if (!tile_of8(base, 72, 44, pm, pn)) continue;
      if (last && (pm % 9) == 0) continue;
      f32x16 acc[4][2];
      {
        const f32x16 z = {0.f, 0.f, 0.f, 0.f, 0.f, 0.f, 0.f, 0.f, 0.f, 0.f, 0.f, 0.f, 0.f, 0.f, 0.f, 0.f};
#pragma unroll
        for (int mi = 0; mi < 4; ++mi) { acc[mi][0] = z; acc[mi][1] = z; }
      }
      const int c0 = pn * 64;
      gemm_big(acc, XN + (size_t)pm * 256 * 1024, 1024, wbf + W_UP + (size_t)c0 * 1024, wbf + W_UP + (size_t)(DFF + c0) * 1024, 1024, 1024, smem);
      const int tid = tid_(), lane = tid & 63, wave = tid >> 6, wr = wave >> 1, wc = wave & 1, odd = lane & 1;
#pragma unroll
      for (int mi = 0; mi < 4; ++mi)
#pragma unroll
        for (int ni = 0; ni < 2; ++ni)
#pragma unroll
          for (int i = 0; i < 16; i += 2) {
            const float v0 = acc[mi][ni][i], v1 = acc[mi][ni][i + 1];
            const float recv = dpp_xor1(odd ? v0 : v1);
            const int r = wr * 128 + mi * 32 + (i & 3) + 8 * (i >> 2) + 4 * (lane >> 5) + odd;
            const int c = wc * 64 + ni * 32 + (lane & 31) - odd;
            *(unsigned*)(smem + r * 272 + c * 2) = odd ? pk2(recv, v1) : pk2(v0, recv);
          }
      __syncthreads();
      {
        const int ch8 = tid & 7;
        const float* fw = p.ffn_conv_w + (size_t)l * 3 * 5632 + c0 + ch8 * 8;
        float wa[3][8], wg[3][8];
#pragma unroll
        for (int jj = 0; jj < 3; ++jj)
#pragma unroll
          for (int q = 0; q < 2; ++q) {
            const float4 va = *(const float4*)(fw + jj * 5632 + 4 * q), vg = *(const float4*)(fw + jj * 5632 + DFF + 4 * q);
            wa[jj][4 * q] = va.x; wa[jj][4 * q + 1] = va.y; wa[jj][4 * q + 2] = va.z; wa[jj][4 * q + 3] = va.w;
            wg[jj][4 * q] = vg.x; wg[jj][4 * q + 1] = vg.y; wg[jj][4 * q + 2] = vg.z; wg[jj][4 * q + 3] = vg.w;
          }
        bf16_t* arow = ACT + (size_t)pm * 256 * DFF + c0 + ch8 * 8;
#pragma unroll 2
        for (int it = 0; it < 8; ++it) {
          const int r = 1 + (tid >> 3) + 32 * it;
          if (r < 255) {
            const char* ta = smem + r * 272 + ch8 * 16;
            float fp[8], fc[8], fn[8], gp[8], gc[8], gn[8];
            unpack8(*(const u32x4*)(ta - 272), fp); unpack8(*(const u32x4*)ta, fc); unpack8(*(const u32x4*)(ta + 272), fn);
            unpack8(*(const u32x4*)(ta - 272 + 128), gp); unpack8(*(const u32x4*)(ta + 128), gc); unpack8(*(const u32x4*)(ta + 272 + 128), gn);
            unsigned o[4];
#pragma unroll
            for (int e = 0; e < 4; ++e) {
              const float a0 = wa[0][2 * e] * fp[2 * e] + wa[1][2 * e] * fc[2 * e] + wa[2][2 * e] * fn[2 * e];
              const float a1 = wa[0][2 * e + 1] * fp[2 * e + 1] + wa[1][2 * e + 1] * fc[2 * e + 1] + wa[2][2 * e + 1] * fn[2 * e + 1];
              const float g0 = wg[0][2 * e] * gp[2 * e] + wg[1][2 * e] * gc[2 * e] + wg[2][2 * e] * gn[2 * e];
              const float g1 = wg[0][2 * e + 1] * gp[2 * e + 1] + wg[1][2 * e + 1] * gc[2 * e + 1] + wg[2][2 * e + 1] * gn[2 * e + 1];
              o[e] = pk2(a0 * siluf_(g0), a1 * siluf_(g1));
            }
            *(u32x4*)(arow + (size_t)r * DFF) = mk4(o[0], o[1], o[2], o[3]);
          }
        }
      }
      if (tid < 64) {
        const int er = tid >> 4, ck = tid & 15;
        const int rr = er < 2 ? er : 252 + er;
        *(u32x4*)((bf16_t*)(p.ws + OFF_EDGE) + ((size_t)(pm * 44 + pn) * 4 + er) * 128 + ck * 8) = *(const u32x4*)(smem + rr * 272 + ck * 16);
      }
    }
    GBAR();
    {
      const bf16_t* edge = (const bf16_t*)(p.ws + OFF_EDGE);
      const float* fwb = p.ffn_conv_w + (size_t)l * 3 * 5632;
      for (int idx = bid_() * 256 + tid_(); idx < 72 * 44 * 16; idx += G * 256) {
        const int ch8 = idx & 7, e = (idx >> 3) & 1, tp = idx >> 4;
        const int pm = tp / 44, pn = tp - pm * 44, t9 = pm % 9;
        if (last && t9 == 0) continue;
        const bf16_t* eb = edge + ((size_t)(pm * 44 + pn) * 4) * 128 + ch8 * 8;
        const u32x4 z = mk4(0u, 0u, 0u, 0u);
        u32x4 pa, pg, ca, cg, na, ng;
        if (e == 0) {
          const bool hp = !(t9 == 0 || t9 == 1);
          const bf16_t* pb = eb - (size_t)44 * 4 * 128 + 3 * 128;
          pa = hp ? *(const u32x4*)pb : z; pg = hp ? *(const u32x4*)(pb + 64) : z;
          ca = *(const u32x4*)eb; cg = *(const u32x4*)(eb + 64);
          na = *(const u32x4*)(eb + 128); ng = *(const u32x4*)(eb + 128 + 64);
        } else {
          const bool hn = !(t9 == 0 || t9 == 8);
          const bf16_t* nb = eb + (size_t)44 * 4 * 128;
          pa = *(const u32x4*)(eb + 2 * 128); pg = *(const u32x4*)(eb + 2 * 128 + 64);
          ca = *(const u32x4*)(eb + 3 * 128); cg = *(const u32x4*)(eb + 3 * 128 + 64);
          na = hn ? *(const u32x4*)nb : z; ng = hn ? *(const u32x4*)(nb + 64) : z;
        }
        float fp[8], fc[8], fn[8], gp[8], gc[8], gn[8];
        unpack8(pa, fp); unpack8(ca, fc); unpack8(na, fn); unpack8(pg, gp); unpack8(cg, gc); unpack8(ng, gn);
        const float* fw = fwb + pn * 64 + ch8 * 8;
        unsigned o[4];
#pragma unroll
        for (int q = 0; q < 4; ++q) {
          float av[2], gv[2];
#pragma unroll
          for (int x = 0; x < 2; ++x) {
            const int c = 2 * q + x;
            av[x] = fw[c] * fp[c] + fw[5632 + c] * fc[c] + fw[11264 + c] * fn[c];
            gv[x] = fw[DFF + c] * gp[c] + fw[5632 + DFF + c] * gc[c] + fw[11264 + DFF + c] * gn[c];
          }
          o[q] = pk2(av[0] * siluf_(gv[0]), av[1] * siluf_(gv[1]));
        }
        *(u32x4*)(ACT + (size_t)(pm * 256 + (e ? 255 : 0)) * DFF + pn * 64 + ch8 * 8) = mk4(o[0], o[1], o[2], o[3]);
      }
    }
    GBAR();
    resid_gemm(ACT, DFF, wbf + W_DN, DFF, 5, false);
    GBAR();
  }
}

extern "C" void kernel_launch(void* const* d_in, const int* in_sizes, int n_in, void* d_out, int out_size, void* d_ws, size_t ws_size,
                              hipStream_t stream) {
  if (ws_size < OFF_END) return;
  static int grid_blocks = 0;
  if (!grid_blocks) {
    int dev = 0, cus = 0, per_cu = 0;
    hipGetDevice(&dev);
    hipDeviceGetAttribute(&cus, hipDeviceAttributeMultiprocessorCount, dev);
    hipOccupancyMaxActiveBlocksPerMultiprocessor(&per_cu, hybrid_fwd, 256, 0);
    if (per_cu > 2) per_cu = 2;
    if (per_cu < 1) per_cu = 1;
    grid_blocks = cus * per_cu;
  }
  Params p{};
  const float** pp = (const float**)&p;
  for (int i = 0; i < 22; ++i) pp[i] = (const float*)d_in[i];
  p.out = (float*)d_out;
  p.ws = (char*)d_ws;
  hipMemsetAsync((char*)d_ws + OFF_BAR, 0, 16384, stream);
  void* args[] = {&p};
  hipLaunchCooperativeKernel((void*)hybrid_fwd, dim3(grid_blocks), dim3(256), args, 0, stream);
}
```
